# Optimizing an MI355X kernel written in HIP

```python
import jax
import jax.numpy as jnp
from jax import lax
import numpy as np

D_MODEL = 2048
BATCH = 4
SEQ = 2048
DEPTH = 4

CHUNK = 64
Q_BLOCK = 128
ATTN_WIDTH = D_MODEL // 2
ATTN_HEAD_DIM = 128
ATTN_HEADS = ATTN_WIDTH // ATTN_HEAD_DIM
CONV_CH = D_MODEL // 4
DW_CONV_LEN = 31
LRU_WIDTH = D_MODEL // 4
LRU_BLOCKS = 4
LRU_BLOCK_DIM = LRU_WIDTH // LRU_BLOCKS
LRU_CONV_LEN = 4
LRU_C = 8.0
MIX_WIDTH = ATTN_WIDTH + CONV_CH + LRU_WIDTH
IN_COLS = 3 * ATTN_WIDTH + 2 * CONV_CH + 2 * LRU_WIDTH
SPLITS = [ATTN_WIDTH, 2 * ATTN_WIDTH, 3 * ATTN_WIDTH,
          3 * ATTN_WIDTH + CONV_CH, 3 * ATTN_WIDTH + 2 * CONV_CH,
          3 * ATTN_WIDTH + 2 * CONV_CH + LRU_WIDTH]
D_FF = -(-8 * D_MODEL // (3 * 256)) * 256
EPS = 1e-6

kernel_name = "hybrid_stickbreak_conformer_rglru_block"


def rms_norm(x, g):
    xf = x.astype(jnp.float32)
    y = xf * lax.rsqrt(jnp.mean(xf * xf, axis=-1, keepdims=True) + EPS)
    return (y * g.astype(jnp.float32)).astype(x.dtype)


def layer_norm(x, g, b):
    xf = x.astype(jnp.float32)
    mu = jnp.mean(xf, axis=-1, keepdims=True)
    xc = xf - mu
    y = xc * lax.rsqrt(jnp.mean(xc * xc, axis=-1, keepdims=True) + EPS)
    return (y * g.astype(jnp.float32) + b.astype(jnp.float32)).astype(x.dtype)


def causal_depthwise_conv(x, w, b):
    width, ch = w.shape
    y = lax.conv_general_dilated(x, w[:, None, :].astype(x.dtype), window_strides=(1,),
                                 padding=[(width - 1, 0)],
                                 dimension_numbers=('NWC', 'WIO', 'NWC'),
                                 feature_group_count=ch)
    return y + b.astype(x.dtype)


def stick_breaking_attention(q, k, v):
    _, s_len, _, dh = q.shape
    scale = dh ** -0.5
    outs = []
    for blk in range(s_len // Q_BLOCK):
        q0 = blk * Q_BLOCK
        kv_len = q0 + Q_BLOCK
        qb = q[:, q0:kv_len].astype(jnp.float32)
        kb = k[:, :kv_len].astype(jnp.float32)
        vb = v[:, :kv_len].astype(jnp.float32)
        z = jnp.einsum('bqhd,bkhd->bhqk', qb, kb) * scale
        q_pos = q0 + jnp.arange(Q_BLOCK)
        k_pos = jnp.arange(kv_len)
        mask = k_pos[None, :] < q_pos[:, None]
        log_keep = jnp.where(mask, jax.nn.log_sigmoid(-z), 0.0)
        log_later = lax.cumsum(log_keep, axis=3, reverse=True) - log_keep
        log_w = jax.nn.log_sigmoid(z) + log_later
        w = jnp.where(mask, jnp.exp(log_w), 0.0)
        outs.append(jnp.einsum('bhqk,bkhd->bqhd', w, vb))
    return jnp.concatenate(outs, axis=1).astype(v.dtype)


def conformer_conv(c_val, c_gate, dw_w, dw_b, ln_g, ln_b):
    u = c_val * jax.nn.sigmoid(c_gate)
    u = causal_depthwise_conv(u, dw_w, dw_b)
    u = layer_norm(u, ln_g, ln_b)
    return jax.nn.silu(u)


def griffin_recurrent(r_x, r_y, conv_w, conv_b, w_a, b_a, w_i, b_i, lam):
    xr = causal_depthwise_conv(r_x, conv_w, conv_b)
    bsz, s_len, width = xr.shape
    xb = xr.reshape(bsz, s_len, LRU_BLOCKS, LRU_BLOCK_DIM)
    gate_a = jnp.einsum('bsni,nio->bsno', xb, w_a).reshape(bsz, s_len, width) + b_a
    gate_i = jnp.einsum('bsni,nio->bsno', xb, w_i).reshape(bsz, s_len, width) + b_i
    r = jax.nn.sigmoid(gate_a.astype(jnp.float32))
    i = jax.nn.sigmoid(gate_i.astype(jnp.float32))
    log_a = -LRU_C * r * jax.nn.softplus(-lam.astype(jnp.float32))
    a = jnp.exp(log_a)
    b = jnp.sqrt(-jnp.expm1(2.0 * log_a)) * (i * xr.astype(jnp.float32))

    def combine(left, right):
        a1, b1 = left
        a2, b2 = right
        return a1 * a2, a2 * b1 + b2

    _, h = lax.associative_scan(combine, (a, b), axis=1)
    return (h * jax.nn.gelu(r_y.astype(jnp.float32))).astype(r_x.dtype)


def setup_inputs(seed: int = 0) -> dict:
    key = jax.random.key(seed)
    ks = jax.random.split(key, 25)
    f32 = jnp.float32

    def nrm(k, shape, scale):
        return jax.random.normal(k, shape, f32) * scale

    def gain(k, shape):
        return 1.0 + 0.02 * jax.random.normal(k, shape, f32)

    u = jax.random.uniform(ks[20], (DEPTH, LRU_WIDTH), f32, 0.9, 0.999)
    a_base = u ** (1.0 / LRU_C)
    lam = jnp.log(a_base) - jnp.log1p(-a_base)
    return {
        'x': jax.random.normal(ks[0], (BATCH, SEQ, D_MODEL), f32),
        'w_in': nrm(ks[1], (DEPTH, D_MODEL, IN_COLS), D_MODEL ** -0.5),
        'w_out': nrm(ks[2], (DEPTH, MIX_WIDTH, D_MODEL), MIX_WIDTH ** -0.5),
        'g_pre_mix': gain(ks[3], (DEPTH, D_MODEL)),
        'g_post_mix': gain(ks[4], (DEPTH, D_MODEL)),
        'g_pre_ffn': gain(ks[5], (DEPTH, D_MODEL)),
        'g_post_ffn': gain(ks[6], (DEPTH, D_MODEL)),
        'g_attn_grp': gain(ks[7], (DEPTH, ATTN_WIDTH)),
        'g_conv_grp': gain(ks[8], (DEPTH, CONV_CH)),
        'g_lru_grp': gain(ks[9], (DEPTH, LRU_WIDTH)),
        'dw_conv_w': nrm(ks[10], (DEPTH, DW_CONV_LEN, CONV_CH), DW_CONV_LEN ** -0.5),
        'dw_conv_b': nrm(ks[11], (DEPTH, CONV_CH), 0.01),
        'conv_ln_g': gain(ks[12], (DEPTH, CONV_CH)),
        'conv_ln_b': nrm(ks[13], (DEPTH, CONV_CH), 0.01),
        'lru_conv_w': nrm(ks[14], (DEPTH, LRU_CONV_LEN, LRU_WIDTH), LRU_CONV_LEN ** -0.5),
        'lru_conv_b': nrm(ks[15], (DEPTH, LRU_WIDTH), 0.01),
        'lru_w_a': nrm(ks[16], (DEPTH, LRU_BLOCKS, LRU_BLOCK_DIM, LRU_BLOCK_DIM), LRU_BLOCK_DIM ** -0.5),
        'lru_b_a': nrm(ks[17], (DEPTH, LRU_WIDTH), 0.01),
        'lru_w_i': nrm(ks[18], (DEPTH, LRU_BLOCKS, LRU_BLOCK_DIM, LRU_BLOCK_DIM), LRU_BLOCK_DIM ** -0.5),
        'lru_b_i': nrm(ks[19], (DEPTH, LRU_WIDTH), 0.01),
        'lru_lambda': lam,
        'w_gate': nrm(ks[21], (DEPTH, D_MODEL, D_FF), D_MODEL ** -0.5),
        'w_up': nrm(ks[22], (DEPTH, D_MODEL, D_FF), D_MODEL ** -0.5),
        'w_down': nrm(ks[23], (DEPTH, D_FF, D_MODEL), D_FF ** -0.5),
    }


def reference(x, w_in, w_out, g_pre_mix, g_post_mix, g_pre_ffn, g_post_ffn,
              g_attn_grp, g_conv_grp, g_lru_grp, dw_conv_w, dw_conv_b, conv_ln_g, conv_ln_b,
              lru_conv_w, lru_conv_b, lru_w_a, lru_b_a, lru_w_i, lru_b_i, lru_lambda,
              w_gate, w_up, w_down):
    bsz, s_len, _ = x.shape
    heads = (bsz, s_len, ATTN_HEADS, ATTN_HEAD_DIM)
    h = x
    for l in range(DEPTH):
        u = rms_norm(h, g_pre_mix[l])
        proj = jnp.einsum('bsd,dc->bsc', u, w_in[l])
        q, k, v, c_val, c_gate, r_x, r_y = jnp.split(proj, SPLITS, axis=-1)
        y_attn = stick_breaking_attention(q.reshape(heads), k.reshape(heads),
                                          v.reshape(heads)).reshape(bsz, s_len, ATTN_WIDTH)
        y_conv = conformer_conv(c_val, c_gate, dw_conv_w[l], dw_conv_b[l],
                                conv_ln_g[l], conv_ln_b[l])
        y_lru = griffin_recurrent(r_x, r_y, lru_conv_w[l], lru_conv_b[l], lru_w_a[l], lru_b_a[l],
                                  lru_w_i[l], lru_b_i[l], lru_lambda[l])
        mixed = jnp.concatenate([rms_norm(y_attn, g_attn_grp[l]),
                                 rms_norm(y_conv, g_conv_grp[l]),
                                 rms_norm(y_lru, g_lru_grp[l])], axis=-1)
        h = h + rms_norm(jnp.einsum('bsc,cd->bsd', mixed, w_out[l]), g_post_mix[l])
        u = rms_norm(h, g_pre_ffn[l])
        f = jax.nn.silu(jnp.einsum('bsd,df->bsf', u, w_gate[l])) * jnp.einsum('bsd,df->bsf', u, w_up[l])
        h = h + rms_norm(jnp.einsum('bsf,fd->bsd', f, w_down[l]), g_post_ffn[l])
    return h
```

```cpp
#include <hip/hip_runtime.h>
#include <hip/hip_cooperative_groups.h>
#include <cstdio>
#include <cstdint>
namespace cg = cooperative_groups;
namespace pg8 {
#define PG8_LAS __attribute__((address_space(3)))
typedef unsigned short bf16_t;
typedef short bf16x8 __attribute__((ext_vector_type(8)));
typedef float f32x4 __attribute__((ext_vector_type(4)));
typedef unsigned u32x4 __attribute__((ext_vector_type(4)));
constexpr int BM = 256, BK = 64, HALF = 128, HTB = HALF * BK * 2  , STAGE_BYTES = 8 * HTB, NXCD = 8, WGM = 8;

__host__ __device__ __forceinline__ int lds_byte(int r, int c) { const int st = (r >> 4) * 2 + (c >> 5), rr = r & 15, cc = c & 31, ob = rr * 64 + cc * 2; return st * 1024 + (ob ^ (((ob >> 9) & 1) << 5)); }
__host__ __device__ __forceinline__ void stage_rc(int b, int& R, int& C) { const int st = b / 1024, sb = b % 1024, swz = sb ^ (((sb >> 9) & 1) << 5); R = (st >> 1) * 16 + swz / 64; C = (st & 1) * 32 + (swz % 64) / 2; }
__host__ __device__ __forceinline__ int perm32(int rho) { const int n = rho >> 4, i = rho & 15; return 8 * (i >> 2) + 4 * n + (i & 3); }

struct Unit { int pm, pn; };
struct Gemm { const bf16_t* A; const bf16_t* Bt; int M, N, K; };

struct StaticOrder {
    int nM, nN, nwg, G, c;
    __host__ __device__ void init(int M, int N, int G_, int c_) { nM = M / BM; nN = N / BM; nwg = nM * nN; G = G_; c = c_; }
    __host__ __device__ bool next(int i, Unit& u) const {
        const long L = (long)i * G + c; if (L >= nwg) return false;
        int wgid = (int)L; { const int q = nwg / NXCD, r = nwg % NXCD, xcd = wgid % NXCD, off = wgid / NXCD; wgid = (xcd < r ? xcd * (q + 1) : r * (q + 1) + (xcd - r) * q) + off; }
        const int nig = WGM * nN, gid = wgid / nig, fm = gid * WGM, gsz = (nM - fm) < WGM ? (nM - fm) : WGM;
        u.pm = fm + ((wgid % nig) % gsz); u.pn = (wgid % nig) / gsz; return true;
    }
    __device__ __forceinline__ void a_ready(const Unit&) const {}
    __device__ __forceinline__ void done(const Unit&) const {}
};


__device__ __forceinline__ float fast_sigmoid(float x) { return __builtin_amdgcn_rcpf(1.0f + __expf(-x)); }
__device__ __forceinline__ unsigned cvt2(float lo, float hi) { typedef float f2_t __attribute__((ext_vector_type(2))); typedef __bf16 b2_t __attribute__((ext_vector_type(2))); f2_t v = {lo, hi}; b2_t b = __builtin_convertvector(v, b2_t); return __builtin_bit_cast(unsigned, b); }

template <int MODE, size_t OFF0, size_t OFF1, size_t OFF2> struct EpiWs {
    static constexpr bool PERM = (MODE != 3), AFTER_DRAIN = false;
    unsigned char* ws;
    __device__ __forceinline__ void operator()(const f32x4 (&acc)[2][2][4][2], const Unit& u, int wr, int wc, int fr, int fq) const {
        const int row0 = u.pm * BM + wr * 64 + fr;
        if constexpr (MODE == 3) {
            float* C = (float*)(ws + OFF0); constexpr int ldc = 2048; const int col0 = u.pn * BM + wc * 32 + 4 * fq;
#pragma unroll
            for (int ai = 0; ai < 2; ++ai)
#pragma unroll
                for (int m = 0; m < 4; ++m) { float* rowp = C + (size_t)(row0 + ai * HALF + m * 16) * ldc + col0;
#pragma unroll
                    for (int bj = 0; bj < 2; ++bj)
#pragma unroll
                        for (int n = 0; n < 2; ++n) *(f32x4*)(rowp + bj * HALF + n * 16) = acc[ai][bj][m][n]; }
        } else {
            const bool pair = (MODE == 2) || (MODE == 0 && u.pn >= 8 && u.pn < 12);
            if (pair) {
                constexpr int ld1 = (MODE == 2) ? 5632 : 512; constexpr int t1 = (MODE == 2) ? 0 : 8; constexpr bool swiglu = (MODE == 2);
                bf16_t* base = (bf16_t*)(ws + OFF1) + (size_t)row0 * ld1 + (u.pn - t1) * 128 + wc * 32 + 8 * fq;
#pragma unroll
                for (int ai = 0; ai < 2; ++ai)
#pragma unroll
                    for (int m = 0; m < 4; ++m) { bf16_t* rowp = base + (size_t)(ai * HALF + m * 16) * ld1;
                        float r[8];
#pragma unroll
                        for (int n = 0; n < 2; ++n)
#pragma unroll
                            for (int j = 0; j < 4; ++j) { const float x0 = acc[ai][0][m][n][j], x1 = acc[ai][1][m][n][j]; const float s = fast_sigmoid(x1); r[4 * n + j] = swiglu ? x0 * x1 * s : x0 * s; }
                        u32x4 w; w.x = cvt2(r[0], r[1]); w.y = cvt2(r[2], r[3]); w.z = cvt2(r[4], r[5]); w.w = cvt2(r[6], r[7]);
                        *(u32x4*)rowp = w; }
            } else {
                bf16_t* base; int ld, colt;
                if (MODE == 1) { base = (bf16_t*)(ws + OFF0); ld = 8192; colt = u.pn * BM; }
                else if (u.pn < 8) { base = (bf16_t*)(ws + OFF0); ld = 2048; colt = u.pn * BM; } else { base = (bf16_t*)(ws + OFF2); ld = 1024; colt = (u.pn - 12) * BM; }
                base += (size_t)row0 * ld + colt + wc * 32 + 8 * fq;
#pragma unroll
                for (int ai = 0; ai < 2; ++ai)
#pragma unroll
                    for (int m = 0; m < 4; ++m) { bf16_t* rowp = base + (size_t)(ai * HALF + m * 16) * ld;
#pragma unroll
                        for (int bj = 0; bj < 2; ++bj) { const f32x4 v0 = acc[ai][bj][m][0], v1 = acc[ai][bj][m][1];
                            u32x4 w; w.x = cvt2(v0[0], v0[1]); w.y = cvt2(v0[2], v0[3]); w.z = cvt2(v1[0], v1[1]); w.w = cvt2(v1[2], v1[3]);
                            *(u32x4*)(rowp + bj * HALF) = w; } }
            }
        }
    }
};
template <class Epi, class Sched, bool ALIGN_EPI = false, bool SP2 = false>
__device__ __forceinline__ void gemm_phase(PG8_LAS unsigned char* lds, const Gemm g, const Sched& S, const Epi& E) {
    const int tid = threadIdx.x, wid = __builtin_amdgcn_readfirstlane(tid >> 6), lane = tid & 63, wr = wid >> 2, wc = wid & 3, fr = lane & 15, fq = lane >> 4;
    const int K = g.K, nt = K / BK;
    unsigned voffA[2], voffB[2];
#pragma unroll
    for (int i = 0; i < 2; ++i) { int R, C; stage_rc(tid * 16 + i * 8192, R, C); const int Rb = Epi::PERM ? ((R & ~31) + perm32(R & 31)) : R;
        voffA[i] = (unsigned)(R * K + C) * 2u; voffB[i] = (unsigned)(Rb * K + C) * 2u; }
    const size_t kstep = (size_t)(BK * 2);
    const size_t hstep = (size_t)HALF * K * 2;
    const size_t tstep = 2 * hstep;
    const unsigned ldsw = (unsigned)wid * 1024u;
    const int aoff = lds_byte(wr * 64 + fr, fq * 8), boff = lds_byte(wc * 32 + fr, fq * 8);
#define PG8_SA(b, h) (((b) * 2 + (h)) * HTB)
#define PG8_SB(b, h) ((4 + (b) * 2 + (h)) * HTB)
#define PG8_STAGE(bufoff, gbase, voff) do { _Pragma("unroll") for (int _i = 0; _i < 2; ++_i) \
        __builtin_amdgcn_global_load_lds((const unsigned*)((const char*)(gbase) + (voff)[_i]), (PG8_LAS unsigned*)(lds + (bufoff) + ldsw + _i * 8192), 16, 0, 0); } while (0)
#define PG8_LDA(dst, b, h) do { _Pragma("unroll") for (int m = 0; m < 4; ++m) _Pragma("unroll") for (int k = 0; k < 2; ++k) dst[m][k] = *(const PG8_LAS bf16x8*)(lds + PG8_SA(b, h) + aoff + m * 2048 + k * 1024); } while (0)
#define PG8_LDB(dst, b, h) do { _Pragma("unroll") for (int n = 0; n < 2; ++n) _Pragma("unroll") for (int k = 0; k < 2; ++k) dst[n][k] = *(const PG8_LAS bf16x8*)(lds + PG8_SB(b, h) + boff + n * 2048 + k * 1024); } while (0)
#define PG8_MMA(ai, bj, At, Bt) do { __builtin_amdgcn_s_setprio(1); _Pragma("unroll") for (int m = 0; m < 4; ++m) _Pragma("unroll") for (int n = 0; n < 2; ++n) _Pragma("unroll") for (int k = 0; k < 2; ++k) \
        acc[ai][bj][m][n] = __builtin_amdgcn_mfma_f32_16x16x32_bf16(Bt[n][k], At[m][k], acc[ai][bj][m][n], 0, 0, 0); __builtin_amdgcn_s_setprio(0); } while (0)
#define PG8_WAIT_V(n) asm volatile("s_waitcnt vmcnt(" #n ")" ::: "memory")
#define PG8_WAIT_L(n) asm volatile("s_waitcnt lgkmcnt(" #n ")" ::: "memory")
#define PG8_BAR __builtin_amdgcn_s_barrier()
#define PG8_SCHED __builtin_amdgcn_sched_barrier(0)
    Unit cur, nxt; int ui = 0;
    if (!S.next(0, cur)) return;
    f32x4 acc[2][2][4][2];
#pragma unroll
    for (int a = 0; a < 2; ++a)
#pragma unroll
        for (int b = 0; b < 2; ++b)
#pragma unroll
            for (int m = 0; m < 4; ++m)
#pragma unroll
                for (int n = 0; n < 2; ++n) acc[a][b][m][n] = (f32x4){0.f, 0.f, 0.f, 0.f};
    bf16x8 At[4][2], B0[2][2], B1[2][2];
    const char* cA = (const char*)g.A + (size_t)cur.pm * tstep; const char* cB = (const char*)g.Bt + (size_t)cur.pn * tstep;
    S.a_ready(cur);
    if constexpr (SP2) {
        PG8_STAGE(PG8_SB(0, 0), cB, voffB); PG8_STAGE(PG8_SB(0, 1), cB + hstep, voffB); PG8_STAGE(PG8_SA(0, 0), cA, voffA); PG8_STAGE(PG8_SA(0, 1), cA + hstep, voffA);
        if (wr == 1) PG8_BAR;
        PG8_WAIT_V(2); PG8_BAR;
        PG8_STAGE(PG8_SB(1, 0), cB + kstep, voffB); PG8_STAGE(PG8_SA(1, 0), cA + kstep, voffA); PG8_STAGE(PG8_SB(1, 1), cB + hstep + kstep, voffB);
        PG8_WAIT_V(6); PG8_BAR;
    } else {
        PG8_STAGE(PG8_SB(0, 0), cB, voffB); PG8_STAGE(PG8_SA(0, 0), cA, voffA); PG8_STAGE(PG8_SB(0, 1), cB + hstep, voffB); PG8_STAGE(PG8_SA(0, 1), cA + hstep, voffA);
        if (wr == 1) PG8_BAR;
        PG8_WAIT_V(4); PG8_BAR;
        PG8_STAGE(PG8_SB(1, 0), cB + kstep, voffB); PG8_STAGE(PG8_SA(1, 0), cA + kstep, voffA); PG8_STAGE(PG8_SB(1, 1), cB + hstep + kstep, voffB);
        PG8_WAIT_V(6); PG8_BAR;
    }
    for (;;) {
        const bool has_next = S.next(ui + 1, nxt);
        const char* nA = has_next ? (const char*)g.A + (size_t)nxt.pm * tstep : cA; const char* nB = has_next ? (const char*)g.Bt + (size_t)nxt.pn * tstep : cB;
        for (int t = 0; t < nt; t += 2) {
            const bool last = (t == nt - 2);
            const char* a1 = cA + (size_t)(t + 1) * kstep;
            const char* a2 = last ? nA : cA + (size_t)(t + 2) * kstep; const char* b2 = last ? nB : cB + (size_t)(t + 2) * kstep;
            const char* a3 = a2 + kstep; const char* b3 = b2 + kstep;
            if (last && has_next) S.a_ready(nxt);
            if constexpr (SP2) {
            PG8_LDB(B0, 0, 0); PG8_LDB(B1, 0, 1); PG8_SCHED; PG8_LDA(At, 0, 0); PG8_STAGE(PG8_SA(1, 1), a1 + hstep, voffA);
            PG8_WAIT_V(8); PG8_WAIT_L(0); PG8_BAR; PG8_MMA(0, 0, At, B0); PG8_MMA(0, 1, At, B1); PG8_BAR; PG8_SCHED;
            PG8_LDA(At, 0, 1); PG8_STAGE(PG8_SB(0, 0), b2, voffB); PG8_STAGE(PG8_SB(0, 1), b2 + hstep, voffB); PG8_STAGE(PG8_SA(0, 0), a2, voffA);
            PG8_WAIT_V(8); PG8_WAIT_L(0); PG8_BAR; PG8_MMA(1, 0, At, B0); PG8_MMA(1, 1, At, B1); PG8_BAR; PG8_SCHED;
            PG8_LDB(B0, 1, 0); PG8_LDB(B1, 1, 1); PG8_SCHED; PG8_LDA(At, 1, 0); PG8_STAGE(PG8_SA(0, 1), a2 + hstep, voffA);
            PG8_WAIT_V(8); PG8_WAIT_L(0); PG8_BAR; PG8_MMA(0, 0, At, B0); PG8_MMA(0, 1, At, B1); PG8_BAR; PG8_SCHED;
            PG8_LDA(At, 1, 1); PG8_STAGE(PG8_SB(1, 0), b3, voffB); PG8_STAGE(PG8_SB(1, 1), b3 + hstep, voffB); PG8_STAGE(PG8_SA(1, 0), a3, voffA);
            PG8_WAIT_V(8); PG8_WAIT_L(0); PG8_BAR; PG8_MMA(1, 0, At, B0); PG8_MMA(1, 1, At, B1); PG8_BAR; PG8_SCHED;
            } else {
            PG8_LDB(B0, 0, 0); PG8_SCHED; PG8_LDA(At, 0, 0); PG8_STAGE(PG8_SA(1, 1), a1 + hstep, voffA);
            PG8_WAIT_L(8); PG8_BAR; PG8_WAIT_L(0); PG8_MMA(0, 0, At, B0); PG8_BAR; PG8_SCHED;
            PG8_LDB(B1, 0, 1); PG8_STAGE(PG8_SB(0, 0), b2, voffB);
            PG8_BAR; PG8_WAIT_L(0); PG8_MMA(0, 1, At, B1); PG8_BAR;
            PG8_LDA(At, 0, 1); PG8_STAGE(PG8_SA(0, 0), a2, voffA);
            PG8_BAR; PG8_WAIT_L(0); PG8_MMA(1, 0, At, B0); PG8_BAR; PG8_SCHED;
            PG8_STAGE(PG8_SB(0, 1), b2 + hstep, voffB);
            PG8_WAIT_V(6); PG8_BAR; PG8_MMA(1, 1, At, B1); PG8_BAR;
            PG8_LDB(B0, 1, 0); PG8_SCHED; PG8_LDA(At, 1, 0); PG8_STAGE(PG8_SA(0, 1), a2 + hstep, voffA);
            PG8_WAIT_L(8); PG8_BAR; PG8_WAIT_L(0); PG8_MMA(0, 0, At, B0); PG8_BAR; PG8_SCHED;
            PG8_LDB(B1, 1, 1); PG8_STAGE(PG8_SB(1, 0), b3, voffB);
            PG8_BAR; PG8_WAIT_L(0); PG8_MMA(0, 1, At, B1); PG8_BAR;
            PG8_LDA(At, 1, 1); PG8_STAGE(PG8_SA(1, 0), a3, voffA);
            PG8_BAR; PG8_WAIT_L(0); PG8_MMA(1, 0, At, B0); PG8_BAR; PG8_SCHED;
            PG8_STAGE(PG8_SB(1, 1), b3 + hstep, voffB);
            PG8_WAIT_V(6); PG8_BAR; PG8_MMA(1, 1, At, B1); PG8_BAR;
            }
        }
        if constexpr (ALIGN_EPI) { if (wr == 0) PG8_BAR; }
        if constexpr (!Epi::AFTER_DRAIN) { E(acc, cur, wr, wc, fr, fq); S.done(cur); }
        if (!has_next) break;
#pragma unroll
        for (int a = 0; a < 2; ++a)
#pragma unroll
            for (int b = 0; b < 2; ++b)
#pragma unroll
                for (int m = 0; m < 4; ++m)
#pragma unroll
                    for (int n = 0; n < 2; ++n) acc[a][b][m][n] = (f32x4){0.f, 0.f, 0.f, 0.f};
        cur = nxt; cA = nA; cB = nB; ++ui;
        if constexpr (ALIGN_EPI) { if (wr == 1) PG8_BAR; }
    }
    PG8_WAIT_V(0);
    if constexpr (!ALIGN_EPI) { if (wr == 0) PG8_BAR; }
    PG8_BAR;
    if constexpr (Epi::AFTER_DRAIN) { E.fused(acc, cur, wr, wc, fr, fq, lds, wid, lane); S.done(cur); }
#undef PG8_SA
#undef PG8_SB
#undef PG8_STAGE
#undef PG8_LDA
#undef PG8_LDB
#undef PG8_MMA
#undef PG8_WAIT_V
#undef PG8_WAIT_L
#undef PG8_BAR
#undef PG8_SCHED
}
}

constexpr int DM = 2048, NB = 4, SEQ = 2048, DEPTH = 4, MTOK = NB * SEQ;
constexpr int INCOLS = 5120, DFF = 5632, NGU = 2 * DFF;
constexpr float EPS = 1e-6f;
constexpr int NWAVES = 8, NTHREADS = 512;
constexpr int LDS_BYTES = 147456;

constexpr size_t MiB = 1u << 20;
constexpr size_t WS_U = 1 * MiB, WS_QK = 33 * MiB, WS_VT = 65 * MiB, WS_UGLU = 81 * MiB, WS_RXY = 89 * MiB, WS_MIXED = 105 * MiB;
constexpr size_t WS_HLOC = 137 * MiB, WS_ACUM = 153 * MiB, WS_SUM = 169 * MiB, WS_O = 170 * MiB, WS_F = 234 * MiB, WS_W = 322 * MiB;
constexpr size_t WL_MAIN = 0, WL_V = 16 * MiB, WL_OUT = 20 * MiB, WL_GU = 28 * MiB, WL_DOWN = 72 * MiB, WL_LRU = 94 * MiB, WL_STRIDE = 95 * MiB;
constexpr size_t WS_END = WS_W + 4 * WL_STRIDE;

#define LAS __attribute__((address_space(3)))
#define DI __device__ __forceinline__
typedef unsigned short bf16;
typedef short bf16x8 __attribute__((ext_vector_type(8)));
typedef float f32x4 __attribute__((ext_vector_type(4)));
typedef float f32x16 __attribute__((ext_vector_type(16)));
typedef unsigned u32x2 __attribute__((ext_vector_type(2)));
typedef unsigned u32x4 __attribute__((ext_vector_type(4)));
#define MFMA32(a, b, c) __builtin_amdgcn_mfma_f32_32x32x16_bf16((a), (b), (c), 0, 0, 0)

DI unsigned pk2(float lo, float hi) { return pg8::cvt2(lo, hi); }
DI float bf2f(unsigned short b) { return __uint_as_float(((unsigned)b) << 16); }
DI float bflo(unsigned w) { return __uint_as_float(w << 16); }
DI float bfhi(unsigned w) { return __uint_as_float(w & 0xffff0000u); }
DI float sigm(float x) { return __builtin_amdgcn_rcpf(1.0f + __expf(-x)); }
DI float wave_sum(float v) {
#pragma unroll
    for (int o = 1; o < 64; o <<= 1) v += __shfl_xor(v, o);
    return v;
}
#define LDS_WAIT() asm volatile("s_waitcnt lgkmcnt(0)" ::: "memory")

struct Args { const float* in[24]; float* out; unsigned char* ws; };

DI void tr_item(const float* __restrict__ src, int pitch, int col0, int k0, const float* __restrict__ gain, bf16* __restrict__ dst, int dpitch, int drow0, LAS float* scr, int lane) {
#pragma unroll 8
    for (int kk = 0; kk < 64; ++kk) scr[kk * 65 + lane] = src[(size_t)(k0 + kk) * pitch + col0 + lane];
    LDS_WAIT();
    const int c = lane & 7;
    float g[8];
#pragma unroll
    for (int j = 0; j < 8; ++j) g[j] = gain ? gain[k0 + 8 * c + j] : 1.0f;
#pragma unroll
    for (int jj = 0; jj < 8; ++jj) { const int n = (lane >> 3) + 8 * jj; const LAS float* s = scr + (8 * c) * 65 + n;
        u32x4 o; o.x = pk2(s[0] * g[0], s[65] * g[1]); o.y = pk2(s[2 * 65] * g[2], s[3 * 65] * g[3]); o.z = pk2(s[4 * 65] * g[4], s[5 * 65] * g[5]); o.w = pk2(s[6 * 65] * g[6], s[7 * 65] * g[7]);
        *(u32x4*)(dst + (size_t)(drow0 + n) * dpitch + k0 + 8 * c) = o; }
    LDS_WAIT();
}
constexpr int IT_MAIN = 32 * 64, IT_V = 32 * 16, IT_OUT = 32 * 32, IT_GU = 32 * 176, IT_DOWN = 88 * 32, IT_LRU = 32;
constexpr int IT_LAYER = IT_MAIN + IT_V + IT_OUT + IT_GU + IT_DOWN + IT_LRU;
DI void convert_item(const __attribute__((address_space(4))) Args* ap, int it, LAS float* scr, int lane) {
    const int l = it / IT_LAYER; int idx = it % IT_LAYER;
    unsigned char* wl = ap->ws + WS_W + (size_t)l * WL_STRIDE;
    if (idx < IT_MAIN) { const int kb = idx / 64, nb = idx % 64, drow0 = nb * 64, pn = drow0 / 256, w = drow0 % 256;
        const int col0 = pn < 8 ? drow0 : (pn < 12 ? (w < 128 ? 3072 + 128 * (pn - 8) + w : 3584 + 128 * (pn - 8) + (w - 128)) : drow0 + 1024);
        tr_item(ap->in[1] + (size_t)l * DM * INCOLS, INCOLS, col0, kb * 64, ap->in[3] + l * DM, (bf16*)(wl + WL_MAIN), DM, drow0, scr, lane); return; }
    idx -= IT_MAIN;
    if (idx < IT_V) { const int kb = idx / 16, nb = idx % 16;
        tr_item(ap->in[1] + (size_t)l * DM * INCOLS, INCOLS, 2048 + nb * 64, kb * 64, ap->in[3] + l * DM, (bf16*)(wl + WL_V), DM, nb * 64, scr, lane); return; }
    idx -= IT_V;
    if (idx < IT_OUT) { const int kb = idx / 32, nb = idx % 32, k0 = kb * 64;
        const float* g = k0 < 1024 ? ap->in[7] + l * 1024 : (k0 < 1536 ? ap->in[8] + l * 512 - 1024 : ap->in[9] + l * 512 - 1536);
        tr_item(ap->in[2] + (size_t)l * DM * DM, DM, nb * 64, k0, g, (bf16*)(wl + WL_OUT), DM, nb * 64, scr, lane); return; }
    idx -= IT_OUT;
    if (idx < IT_GU) { const int kb = idx / 176, nb = idx % 176, drow0 = nb * 64, pn = drow0 / 256, w = drow0 % 256;
        const float* src = (w < 128 ? ap->in[22] : ap->in[21]) + (size_t)l * DM * DFF; const int col0 = 128 * pn + (w & 127);
        tr_item(src, DFF, col0, kb * 64, ap->in[5] + l * DM, (bf16*)(wl + WL_GU), DM, drow0, scr, lane); return; }
    idx -= IT_GU;
    if (idx < IT_DOWN) { const int kb = idx / 32, nb = idx % 32;
        tr_item(ap->in[23] + (size_t)l * DFF * DM, DM, nb * 64, kb * 64, nullptr, (bf16*)(wl + WL_DOWN), DFF, nb * 64, scr, lane); return; }
    idx -= IT_DOWN;
    { const int gate = idx >> 4, n = (idx >> 2) & 3, kb = (idx >> 1) & 1, nb = idx & 1;
        const float* src = (gate ? ap->in[18] : ap->in[16]) + (size_t)l * 4 * 128 * 128 + (size_t)n * 128 * 128;
        tr_item(src, 128, nb * 64, kb * 64, nullptr, (bf16*)(wl + WL_LRU) + (size_t)(gate * 4 + n) * 128 * 128, 128, nb * 64, scr, lane); }
}

DI void row_init(const float* __restrict__ x, float* __restrict__ h, bf16* __restrict__ u, int gw, int ngw, int lane) {
    for (int m = gw; m < MTOK; m += ngw) {
        const f32x4* xr = (const f32x4*)(x + (size_t)m * DM) + lane; f32x4 v[8]; float ss = 0.f;
#pragma unroll
        for (int j = 0; j < 8; ++j) { v[j] = xr[64 * j]; ss += (v[j].x * v[j].x + v[j].y * v[j].y) + (v[j].z * v[j].z + v[j].w * v[j].w); }
        const float r = rsqrtf(wave_sum(ss) * (1.0f / DM) + EPS);
        f32x4* hr = (f32x4*)(h + (size_t)m * DM) + lane; u32x2* ur = (u32x2*)(u + (size_t)m * DM) + lane;
#pragma unroll
        for (int j = 0; j < 8; ++j) { hr[64 * j] = v[j]; u32x2 w; w.x = pk2(v[j].x * r, v[j].y * r); w.y = pk2(v[j].z * r, v[j].w * r); ur[64 * j] = w; }
    }
}
DI void row_res(const float* __restrict__ o, const float* __restrict__ g, float* __restrict__ h, bf16* __restrict__ u, bool write_u, int gw, int ngw, int lane) {
    for (int m = gw; m < MTOK; m += ngw) {
        const f32x4* orow = (const f32x4*)(o + (size_t)m * DM) + lane; f32x4 v[8]; float ss = 0.f;
#pragma unroll
        for (int j = 0; j < 8; ++j) { v[j] = orow[64 * j]; ss += (v[j].x * v[j].x + v[j].y * v[j].y) + (v[j].z * v[j].z + v[j].w * v[j].w); }
        const float r = rsqrtf(wave_sum(ss) * (1.0f / DM) + EPS);
        f32x4* hr = (f32x4*)(h + (size_t)m * DM) + lane; const f32x4* gr = (const f32x4*)g + lane; float s2 = 0.f;
#pragma unroll
        for (int j = 0; j < 8; ++j) { const f32x4 hv = hr[64 * j], gv = gr[64 * j]; v[j] = hv + v[j] * r * gv; hr[64 * j] = v[j]; s2 += (v[j].x * v[j].x + v[j].y * v[j].y) + (v[j].z * v[j].z + v[j].w * v[j].w); }
        if (write_u) { const float r2 = rsqrtf(wave_sum(s2) * (1.0f / DM) + EPS); u32x2* ur = (u32x2*)(u + (size_t)m * DM) + lane;
#pragma unroll
            for (int j = 0; j < 8; ++j) { u32x2 w; w.x = pk2(v[j].x * r2, v[j].y * r2); w.y = pk2(v[j].z * r2, v[j].w * r2); ur[64 * j] = w; } }
    }
}

DI void attn_unit(const bf16* __restrict__ QK, const bf16* __restrict__ VT, bf16* __restrict__ mixed, int b, int qt, LAS float* red, int wave, int lane) {
    const int n = lane & 31, hh = lane >> 5, h = wave;
    const int qpos = qt * 32 + n; const size_t tokq = (size_t)b * SEQ + qpos;
    const bf16* qp = QK + tokq * 2048 + h * 128 + 8 * hh;
    bf16x8 qf[8];
#pragma unroll
    for (int s = 0; s < 8; ++s) qf[s] = *(const bf16x8*)(qp + 16 * s);
    f32x16 o[4];
#pragma unroll
    for (int d = 0; d < 4; ++d)
#pragma unroll
        for (int i = 0; i < 16; ++i) o[d][i] = 0.f;
    float R = 0.f;
    const float scale = 0.08838834764831845f;
    for (int kt = qt; kt >= 0; --kt) {
        const int key0 = kt * 32;
        const bf16* kp = QK + ((size_t)b * SEQ + key0 + n) * 2048 + 1024 + h * 128 + 8 * hh;
        f32x16 s;
#pragma unroll
        for (int i = 0; i < 16; ++i) s[i] = 0.f;
#pragma unroll
        for (int st = 0; st < 8; ++st) { const bf16x8 kf = *(const bf16x8*)(kp + 16 * st); s = MFMA32(kf, qf[st], s); }
        float lk[16], lw[16];
#pragma unroll
        for (int i = 0; i < 16; ++i) { const float z = s[i] * scale; const int kpos = key0 + 8 * (i >> 2) + 4 * hh + (i & 3);
            const float sp = fmaxf(z, 0.f) + __logf(1.0f + __expf(-fabsf(z)));
            lk[i] = (kpos < qpos) ? -sp : 0.f; lw[i] = (kpos < qpos) ? (z - sp) : -1.0e30f; }
        float gt[4], og[4];
#pragma unroll
        for (int c = 0; c < 4; ++c) { gt[c] = (lk[4 * c] + lk[4 * c + 1]) + (lk[4 * c + 2] + lk[4 * c + 3]); og[c] = __shfl_xor(gt[c], 32); }
        float run = R; float w[16];
#pragma unroll
        for (int c = 3; c >= 0; --c) {
            const float c3 = run + (hh == 0 ? og[c] : 0.f), c2 = c3 + lk[4 * c + 3], c1 = c2 + lk[4 * c + 2], c0 = c1 + lk[4 * c + 1];
            w[4 * c + 3] = __expf(lw[4 * c + 3] + c3); w[4 * c + 2] = __expf(lw[4 * c + 2] + c2); w[4 * c + 1] = __expf(lw[4 * c + 1] + c1); w[4 * c] = __expf(lw[4 * c] + c0);
            run += gt[c] + og[c];
        }
        R = run;
        const bf16* vbase = VT + (size_t)(h * 128 + n) * MTOK + (size_t)b * SEQ + key0 + 4 * hh;
#pragma unroll
        for (int ks = 0; ks < 2; ++ks) {
            u32x4 p; p.x = pk2(w[8 * ks], w[8 * ks + 1]); p.y = pk2(w[8 * ks + 2], w[8 * ks + 3]); p.z = pk2(w[8 * ks + 4], w[8 * ks + 5]); p.w = pk2(w[8 * ks + 6], w[8 * ks + 7]);
            const bf16x8 pf = __builtin_bit_cast(bf16x8, p);
#pragma unroll
            for (int dt = 0; dt < 4; ++dt) { const bf16* vp = vbase + (size_t)(32 * dt) * MTOK + 16 * ks;
                const u32x2 lo = *(const u32x2*)vp, hi = *(const u32x2*)(vp + 8); u32x4 vv; vv.x = lo.x; vv.y = lo.y; vv.z = hi.x; vv.w = hi.y;
                o[dt] = MFMA32(__builtin_bit_cast(bf16x8, vv), pf, o[dt]); }
        }
        if (__all(R < -110.0f)) break;
    }
    float ss = 0.f;
#pragma unroll
    for (int d = 0; d < 4; ++d)
#pragma unroll
        for (int i = 0; i < 16; ++i) ss += o[d][i] * o[d][i];
    ss += __shfl_xor(ss, 32);
    if (hh == 0) red[wave * 32 + n] = ss;
    __syncthreads();
    float tot = 0.f;
#pragma unroll
    for (int w8 = 0; w8 < 8; ++w8) tot += red[w8 * 32 + n];
    const float r = rsqrtf(tot * (1.0f / 1024.0f) + EPS);
    bf16* op = mixed + tokq * 2048 + h * 128 + 4 * hh;
#pragma unroll
    for (int dt = 0; dt < 4; ++dt)
#pragma unroll
        for (int c = 0; c < 4; ++c) { u32x2 wv; wv.x = pk2(o[dt][4 * c] * r, o[dt][4 * c + 1] * r); wv.y = pk2(o[dt][4 * c + 2] * r, o[dt][4 * c + 3] * r);
            *(u32x2*)(op + 32 * dt + 8 * c) = wv; }
    __syncthreads();
}

DI void conv_unit(const bf16* __restrict__ UGLU, const float* __restrict__ dww, const float* __restrict__ dwb, const float* __restrict__ lng, const float* __restrict__ lnb,
                  bf16* __restrict__ mixed, int t0, LAS unsigned char* lds, int tid, int wave, int lane) {
    LAS bf16* Xin = (LAS bf16*)lds;
    LAS float* Y = (LAS float*)(lds + 63488);
    const int bstart = (t0 / SEQ) * SEQ;
    for (int r = wave; r < 62; r += 8) { const int tok = t0 - 30 + r; u32x4 v = {0u, 0u, 0u, 0u};
        if (tok >= bstart) v = *(const u32x4*)(UGLU + (size_t)tok * 512 + lane * 8);
        *(LAS u32x4*)(Xin + r * 512 + lane * 8) = v; }
    __syncthreads();
    const int c = tid;
    float in[62];
#pragma unroll
    for (int r = 0; r < 62; ++r) in[r] = bf2f(Xin[r * 512 + c]);
    float acc[32]; const float bias = dwb[c];
#pragma unroll
    for (int t = 0; t < 32; ++t) acc[t] = bias;
#pragma unroll
    for (int j = 0; j < 31; ++j) { const float wj = dww[j * 512 + c];
#pragma unroll
        for (int t = 0; t < 32; ++t) acc[t] += wj * in[t + j]; }
#pragma unroll
    for (int t = 0; t < 32; ++t) Y[t * 512 + c] = acc[t];
    __syncthreads();
    const f32x4 g0 = *(const f32x4*)(lng + 4 * lane), g1 = *(const f32x4*)(lng + 256 + 4 * lane), b0 = *(const f32x4*)(lnb + 4 * lane), b1 = *(const f32x4*)(lnb + 256 + 4 * lane);
    for (int t = wave; t < 32; t += 8) {
        f32x4 v0 = *(const LAS f32x4*)(Y + t * 512 + 4 * lane), v1 = *(const LAS f32x4*)(Y + t * 512 + 256 + 4 * lane);
        const float mean = wave_sum((v0.x + v0.y) + (v0.z + v0.w) + (v1.x + v1.y) + (v1.z + v1.w)) * (1.0f / 512.0f);
        v0 = v0 - mean; v1 = v1 - mean;
        const float var = wave_sum((v0.x * v0.x + v0.y * v0.y) + (v0.z * v0.z + v0.w * v0.w) + (v1.x * v1.x + v1.y * v1.y) + (v1.z * v1.z + v1.w * v1.w)) * (1.0f / 512.0f);
        const float rs = rsqrtf(var + EPS);
        v0 = v0 * rs * g0 + b0; v1 = v1 * rs * g1 + b1;
        float ss = 0.f;
#pragma unroll
        for (int e = 0; e < 4; ++e) { v0[e] = v0[e] * sigm(v0[e]); v1[e] = v1[e] * sigm(v1[e]); ss += v0[e] * v0[e] + v1[e] * v1[e]; }
        const float r2 = rsqrtf(wave_sum(ss) * (1.0f / 512.0f) + EPS);
        bf16* op = mixed + (size_t)(t0 + t) * 2048 + 1024 + 4 * lane;
        u32x2 w0, w1; w0.x = pk2(v0.x * r2, v0.y * r2); w0.y = pk2(v0.z * r2, v0.w * r2); w1.x = pk2(v1.x * r2, v1.y * r2); w1.y = pk2(v1.z * r2, v1.w * r2);
        *(u32x2*)op = w0; *(u32x2*)(op + 256) = w1;
    }
    __syncthreads();
}

DI void lru1_unit(const bf16* __restrict__ RXY, const float* __restrict__ cw, const float* __restrict__ cb, const bf16* __restrict__ Wl, const float* __restrict__ ba, const float* __restrict__ bi,
                  const float* __restrict__ lam, float* __restrict__ HLOC, float* __restrict__ ACUM, float* __restrict__ SUMA, float* __restrict__ SUMH, int t0, LAS unsigned char* lds, int tid, int wave, int lane) {
    constexpr int XP = 520;
    LAS bf16* X = (LAS bf16*)lds;
    const int bstart = (t0 / SEQ) * SEQ;
    { const int c = tid; const float w0 = cw[c], w1 = cw[512 + c], w2 = cw[1024 + c], w3 = cw[1536 + c], bb = cb[c];
        float x[35];
#pragma unroll
        for (int r = 0; r < 35; ++r) { const int tok = t0 - 3 + r; x[r] = (tok >= bstart) ? bf2f(RXY[(size_t)tok * 1024 + c]) : 0.f; }
#pragma unroll
        for (int t = 0; t < 32; ++t) { const float xr = bb + (w0 * x[t] + w1 * x[t + 1]) + (w2 * x[t + 2] + w3 * x[t + 3]); X[t * XP + c] = (bf16)(pk2(xr, 0.f) & 0xffffu); } }
    __syncthreads();
    const int n = wave >> 1, half = wave & 1, tl = lane & 31, hh = lane >> 5;
    f32x16 acc[2][2];
#pragma unroll
    for (int g = 0; g < 2; ++g)
#pragma unroll
        for (int mt = 0; mt < 2; ++mt)
#pragma unroll
            for (int i = 0; i < 16; ++i) acc[g][mt][i] = 0.f;
#pragma unroll
    for (int s = 0; s < 8; ++s) { const bf16x8 bfr = *(const LAS bf16x8*)(X + tl * XP + 128 * n + 16 * s + 8 * hh);
#pragma unroll
        for (int g = 0; g < 2; ++g)
#pragma unroll
            for (int mt = 0; mt < 2; ++mt) { const bf16* wp = Wl + ((size_t)(g * 4 + n) * 128 + 64 * half + 32 * mt + tl) * 128 + 16 * s + 8 * hh;
                acc[g][mt] = MFMA32(*(const bf16x8*)wp, bfr, acc[g][mt]); } }
    const int chunk = t0 / 32;
#pragma unroll
    for (int mt = 0; mt < 2; ++mt)
#pragma unroll
        for (int cg4 = 0; cg4 < 4; ++cg4) {
            const int ch0 = 128 * n + 64 * half + 32 * mt + 8 * cg4 + 4 * hh;
            const u32x2 xw = *(const LAS u32x2*)(X + tl * XP + ch0);
            const float xr[4] = {bflo(xw.x), bfhi(xw.x), bflo(xw.y), bfhi(xw.y)};
            const f32x4 ba4 = *(const f32x4*)(ba + ch0), bi4 = *(const f32x4*)(bi + ch0), lam4 = *(const f32x4*)(lam + ch0);
            float av[4], bv[4];
#pragma unroll
            for (int e = 0; e < 4; ++e) { const int i = 4 * cg4 + e;
                const float r = sigm(acc[0][mt][i] + ba4[e]), ig = sigm(acc[1][mt][i] + bi4[e]);
                const float sp = log1pf(expf(-lam4[e]));
                const float la = -8.0f * r * sp;
                av[e] = expf(la); bv[e] = sqrtf(-expm1f(2.0f * la)) * (ig * xr[e]); }
#pragma unroll
            for (int d = 1; d < 32; d <<= 1)
#pragma unroll
                for (int e = 0; e < 4; ++e) { const float ap = __shfl_up(av[e], d, 32), bp = __shfl_up(bv[e], d, 32);
                    if (tl >= d) { bv[e] = av[e] * bp + bv[e]; av[e] = av[e] * ap; } }
            const size_t off = (size_t)(t0 + tl) * 512 + ch0;
            *(f32x4*)(HLOC + off) = (f32x4){bv[0], bv[1], bv[2], bv[3]};
            *(f32x4*)(ACUM + off) = (f32x4){av[0], av[1], av[2], av[3]};
            if (tl == 31) { *(f32x4*)(SUMA + (size_t)chunk * 512 + ch0) = (f32x4){av[0], av[1], av[2], av[3]}; *(f32x4*)(SUMH + (size_t)chunk * 512 + ch0) = (f32x4){bv[0], bv[1], bv[2], bv[3]}; }
        }
    __syncthreads();
}

DI void lru2_unit(const bf16* __restrict__ RXY, const float* __restrict__ HLOC, const float* __restrict__ ACUM, const float* __restrict__ SUMA, const float* __restrict__ SUMH,
                  bf16* __restrict__ mixed, int t0, LAS unsigned char* lds, int tid, int wave, int lane) {
    LAS float* carry = (LAS float*)lds;
    const int b = t0 / SEQ, cidx = (t0 % SEQ) / 32;
    { const float* sa = SUMA + (size_t)(b * 64) * 512 + tid; const float* sh = SUMH + (size_t)(b * 64) * 512 + tid; float cr = 0.f;
#pragma unroll 4
        for (int k = 0; k < cidx; ++k) cr = sa[(size_t)k * 512] * cr + sh[(size_t)k * 512];
        carry[tid] = cr; }
    __syncthreads();
    for (int t = wave; t < 32; t += 8) { const size_t tok = (size_t)t0 + t; float y[8]; float ss = 0.f;
#pragma unroll
        for (int jj = 0; jj < 2; ++jj) { const int ch = 4 * lane + 256 * jj;
            const f32x4 hl = *(const f32x4*)(HLOC + tok * 512 + ch), ac = *(const f32x4*)(ACUM + tok * 512 + ch), cr = *(const LAS f32x4*)(carry + ch);
            const u32x2 rw = *(const u32x2*)(RXY + tok * 1024 + 512 + ch); const float ry[4] = {bflo(rw.x), bfhi(rw.x), bflo(rw.y), bfhi(rw.y)};
#pragma unroll
            for (int e = 0; e < 4; ++e) { const float hv = hl[e] + ac[e] * cr[e]; const float x = ry[e];
                const float u2 = 1.5957691216057308f * (x + 0.044715f * x * x * x);
                const float yv = hv * (x * sigm(u2)); y[4 * jj + e] = yv; ss += yv * yv; } }
        const float r = rsqrtf(wave_sum(ss) * (1.0f / 512.0f) + EPS);
        bf16* op = mixed + tok * 2048 + 1536 + 4 * lane;
        u32x2 w0, w1; w0.x = pk2(y[0] * r, y[1] * r); w0.y = pk2(y[2] * r, y[3] * r); w1.x = pk2(y[4] * r, y[5] * r); w1.y = pk2(y[6] * r, y[7] * r);
        *(u32x2*)op = w0; *(u32x2*)(op + 256) = w1;
    }
    __syncthreads();
}

#ifdef SKIP_GEMM
#define GEMMCALL if (0)
#else
#define GEMMCALL
#endif
#define PHASE_PTRS() unsigned z_, zv_; asm volatile("v_mov_b32 %0, 0" : "=v"(zv_)); z_ = __builtin_amdgcn_readfirstlane(zv_); \
    const int tidp = (int)threadIdx.x + (int)zv_, lanep = tidp & 63, wavep = __builtin_amdgcn_readfirstlane(tidp >> 6), gwp = bx * NWAVES + wavep; (void)lanep; (void)gwp; \
    const __attribute__((address_space(4))) Args* ap = (const __attribute__((address_space(4))) Args*)((const __attribute__((address_space(4))) char*)__builtin_amdgcn_kernarg_segment_ptr() + z_); \
    unsigned char* ws = ap->ws; const unsigned char* wl = ws + WS_W + (size_t)l * WL_STRIDE; (void)wl; const int Gp = G + (int)z_, bxp = bx + (int)z_; (void)Gp; (void)bxp
__global__ void __launch_bounds__(NTHREADS, 2) fwd_megakernel(Args a) {
    extern __shared__ __attribute__((aligned(16))) unsigned char lds_raw[];
    cg::grid_group grid = cg::this_grid();
    LAS unsigned char* lds = (LAS unsigned char*)lds_raw;
    const int tid = threadIdx.x, lane = tid & 63, wave = __builtin_amdgcn_readfirstlane(tid >> 6);
    const int G = gridDim.x, bx = blockIdx.x, gw = bx * NWAVES + wave, ngw = G * NWAVES;

    { const int l = 0; PHASE_PTRS(); LAS float* scr = (LAS float*)(lds + wavep * 16640);
#ifndef SKIP_CVT
        for (int it = gwp; it < DEPTH * IT_LAYER; it += ngw) convert_item(ap, it, scr, lanep);
#endif
        row_init(ap->in[0], ap->out, (bf16*)(ws + WS_U), gwp, ngw, lanep); }
    grid.sync();

#pragma unroll 1
    for (int l = 0; l < DEPTH; ++l) {
        { PHASE_PTRS(); pg8::Gemm g{(const pg8::bf16_t*)(ws + WS_U), (const pg8::bf16_t*)(wl + WL_MAIN), MTOK, 4096, DM}; pg8::StaticOrder S; S.init(MTOK, 4096, Gp, bxp);
            typedef pg8::EpiWs<0, WS_QK, WS_UGLU, WS_RXY> EpiT; EpiT E{ws};
            GEMMCALL pg8::gemm_phase<EpiT, pg8::StaticOrder, true, true>(lds, g, S, E); }
        { PHASE_PTRS(); pg8::Gemm g{(const pg8::bf16_t*)(wl + WL_V), (const pg8::bf16_t*)(ws + WS_U), 1024, MTOK, DM}; pg8::StaticOrder S; S.init(1024, MTOK, Gp, bxp);
            typedef pg8::EpiWs<1, WS_VT, 0, 0> EpiT; EpiT E{ws};
            GEMMCALL pg8::gemm_phase<EpiT, pg8::StaticOrder, true, true>(lds, g, S, E); }
        grid.sync();
#pragma unroll 1
        for (int unit = bx; unit < 256; unit += G) {
#ifndef SKIP_ATTN
            { PHASE_PTRS(); attn_unit((const bf16*)(ws + WS_QK), (const bf16*)(ws + WS_VT), (bf16*)(ws + WS_MIXED), unit >> 6, unit & 63, (LAS float*)lds, wavep, lanep); }
#endif
#ifndef SKIP_CONV
            { PHASE_PTRS(); conv_unit((const bf16*)(ws + WS_UGLU), ap->in[10] + (size_t)l * 31 * 512, ap->in[11] + l * 512, ap->in[12] + l * 512, ap->in[13] + l * 512, (bf16*)(ws + WS_MIXED), unit * 32, lds, tidp, wavep, lanep); }
#endif
#ifndef SKIP_LRU1
            { PHASE_PTRS(); float* SUMA = (float*)(ws + WS_SUM);
              lru1_unit((const bf16*)(ws + WS_RXY), ap->in[14] + (size_t)l * 4 * 512, ap->in[15] + l * 512, (const bf16*)(wl + WL_LRU), ap->in[17] + l * 512, ap->in[19] + l * 512, ap->in[20] + l * 512,
                      (float*)(ws + WS_HLOC), (float*)(ws + WS_ACUM), SUMA, SUMA + 256 * 512, unit * 32, lds, tidp, wavep, lanep); }
#endif
        }
        grid.sync();
#pragma unroll 1
        for (int unit = bx; unit < 256; unit += G) { PHASE_PTRS(); float* SUMA = (float*)(ws + WS_SUM);
            lru2_unit((const bf16*)(ws + WS_RXY), (const float*)(ws + WS_HLOC), (const float*)(ws + WS_ACUM), SUMA, SUMA + 256 * 512, (bf16*)(ws + WS_MIXED), unit * 32, lds, tidp, wavep, lanep); }
        grid.sync();
        { PHASE_PTRS(); pg8::Gemm g{(const pg8::bf16_t*)(ws + WS_MIXED), (const pg8::bf16_t*)(wl + WL_OUT), MTOK, DM, DM}; pg8::StaticOrder S; S.init(MTOK, DM, Gp, bxp);
            typedef pg8::EpiWs<3, WS_O, 0, 0> EpiT; EpiT E{ws};
            GEMMCALL pg8::gemm_phase<EpiT, pg8::StaticOrder, true, true>(lds, g, S, E); }
        grid.sync();
        { PHASE_PTRS(); row_res((const float*)(ws + WS_O), ap->in[4] + l * DM, ap->out, (bf16*)(ws + WS_U), true, gwp, ngw, lanep); }
        grid.sync();
        { PHASE_PTRS(); pg8::Gemm g{(const pg8::bf16_t*)(ws + WS_U), (const pg8::bf16_t*)(wl + WL_GU), MTOK, NGU, DM}; pg8::StaticOrder S; S.init(MTOK, NGU, Gp, bxp);
            typedef pg8::EpiWs<2, 0, WS_F, 0> EpiT; EpiT E{ws};
            GEMMCALL pg8::gemm_phase<EpiT, pg8::StaticOrder, true, true>(lds, g, S, E); }
        grid.sync();
        { PHASE_PTRS(); pg8::Gemm g{(const pg8::bf16_t*)(ws + WS_F), (const pg8::bf16_t*)(wl + WL_DOWN), MTOK, DM, DFF}; pg8::StaticOrder S; S.init(MTOK, DM, Gp, bxp);
            typedef pg8::EpiWs<3, WS_O, 0, 0> EpiT; EpiT E{ws};
            GEMMCALL pg8::gemm_phase<EpiT, pg8::StaticOrder, true, true>(lds, g, S, E); }
        grid.sync();
        { PHASE_PTRS(); row_res((const float*)(ws + WS_O), ap->in[6] + l * DM, ap->out, (bf16*)(ws + WS_U), l + 1 < DEPTH, gwp, ngw, lanep); }
        if (l + 1 < DEPTH) grid.sync();
    }
}

extern "C" void kernel_launch(void* const* d_in, const int* in_sizes, int n_in, void* d_out, int out_size, void* d_ws, size_t ws_size, hipStream_t stream) {
    static int grid = 0;
    if (grid == 0) {
        if (n_in != 24 || out_size != MTOK * DM || ws_size < WS_END) { fprintf(stderr, "kernel_launch: unexpected shapes (n_in %d out %d ws %zu)\n", n_in, out_size, ws_size); grid = -1; return; }
        int dev = 0, cus = 0, per_cu = 0;
        (void)hipGetDevice(&dev); (void)hipDeviceGetAttribute(&cus, hipDeviceAttributeMultiprocessorCount, dev);
        (void)hipFuncSetAttribute((const void*)fwd_megakernel, hipFuncAttributeMaxDynamicSharedMemorySize, LDS_BYTES);
        if (hipOccupancyMaxActiveBlocksPerMultiprocessor(&per_cu, (const void*)fwd_megakernel, NTHREADS, LDS_BYTES) != hipSuccess || per_cu < 1) per_cu = 1;
        (void)hipGetLastError();
        grid = cus * per_cu; if (grid > 256) grid = 256; if (grid < 1) grid = 256;
    }
    if (grid < 0) return;
    Args a{};
    for (int i = 0; i < 24; ++i) a.in[i] = (const float*)d_in[i];
    a.out = (float*)d_out; a.ws = (unsigned char*)d_ws;
    void* args[] = {&a};
    hipError_t e = hipLaunchCooperativeKernel((const void*)fwd_megakernel, dim3(grid), dim3(NTHREADS), args, LDS_BYTES, stream);
    if (e != hipSuccess) fprintf(stderr, "kernel_launch: cooperative launch failed: %s (grid %d)\n", hipGetErrorString(e), grid);
}
```

```cpp
#include <hip/hip_runtime.h>
#include <hip/hip_cooperative_groups.h>
#include <cstdio>
#include <cstdint>
namespace cg = cooperative_groups;
namespace pg8 {
#define PG8_LAS __attribute__((address_space(3)))
typedef unsigned short bf16_t;
typedef short bf16x8 __attribute__((ext_vector_type(8)));
typedef float f32x4 __attribute__((ext_vector_type(4)));
typedef unsigned u32x4 __attribute__((ext_vector_type(4)));
constexpr int BM = 256, BK = 64, HALF = 128, HTB = HALF * BK * 2  , STAGE_BYTES = 8 * HTB, NXCD = 8, WGM = 8;

__host__ __device__ __forceinline__ int lds_byte(int r, int c) { const int st = (r >> 4) * 2 + (c >> 5), rr = r & 15, cc = c & 31, ob = rr * 64 + cc * 2; return st * 1024 + (ob ^ (((ob >> 9) & 1) << 5)); }
__host__ __device__ __forceinline__ void stage_rc(int b, int& R, int& C) { const int st = b / 1024, sb = b % 1024, swz = sb ^ (((sb >> 9) & 1) << 5); R = (st >> 1) * 16 + swz / 64; C = (st & 1) * 32 + (swz % 64) / 2; }
__host__ __device__ __forceinline__ int perm32(int rho) { const int n = rho >> 4, i = rho & 15; return 8 * (i >> 2) + 4 * n + (i & 3); }

struct Unit { int pm, pn; };
struct Gemm { const bf16_t* A; const bf16_t* Bt; int M, N, K; };

struct StaticOrder {
    int nM, nN, nwg, G, c;
    __host__ __device__ void init(int M, int N, int G_, int c_) { nM = M / BM; nN = N / BM; nwg = nM * nN; G = G_; c = c_; }
    __host__ __device__ bool next(int i, Unit& u) const {
        const long L = (long)i * G + c; if (L >= nwg) return false;
        int wgid = (int)L; { const int q = nwg / NXCD, r = nwg % NXCD, xcd = wgid % NXCD, off = wgid / NXCD; wgid = (xcd < r ? xcd * (q + 1) : r * (q + 1) + (xcd - r) * q) + off; }
        const int nig = WGM * nN, gid = wgid / nig, fm = gid * WGM, gsz = (nM - fm) < WGM ? (nM - fm) : WGM;
        u.pm = fm + ((wgid % nig) % gsz); u.pn = (wgid % nig) / gsz; return true;
    }
    __device__ __forceinline__ void a_ready(const Unit&) const {}
    __device__ __forceinline__ void done(const Unit&) const {}
};


__device__ __forceinline__ float fast_sigmoid(float x) { return __builtin_amdgcn_rcpf(1.0f + __expf(-x)); }
__device__ __forceinline__ unsigned cvt2(float lo, float hi) { typedef float f2_t __attribute__((ext_vector_type(2))); typedef __bf16 b2_t __attribute__((ext_vector_type(2))); f2_t v = {lo, hi}; b2_t b = __builtin_convertvector(v, b2_t); return __builtin_bit_cast(unsigned, b); }

template <int MODE, size_t OFF0, size_t OFF1, size_t OFF2> struct EpiWs {
    static constexpr bool PERM = (MODE != 3), AFTER_DRAIN = false;
    unsigned char* ws;
    __device__ __forceinline__ void operator()(const f32x4 (&acc)[2][2][4][2], const Unit& u, int wr, int wc, int fr, int fq) const {
        const int row0 = u.pm * BM + wr * 64 + fr;
        if constexpr (MODE == 3) {
            float* C = (float*)(ws + OFF0); constexpr int ldc = 2048; const int col0 = u.pn * BM + wc * 32 + 4 * fq;
#pragma unroll
            for (int ai = 0; ai < 2; ++ai)
#pragma unroll
                for (int m = 0; m < 4; ++m) { float* rowp = C + (size_t)(row0 + ai * HALF + m * 16) * ldc + col0;
#pragma unroll
                    for (int bj = 0; bj < 2; ++bj)
#pragma unroll
                        for (int n = 0; n < 2; ++n) *(f32x4*)(rowp + bj * HALF + n * 16) = acc[ai][bj][m][n]; }
        } else {
            const bool pair = (MODE == 2) || (MODE == 0 && u.pn >= 8 && u.pn < 12);
            if (pair) {
                constexpr int ld1 = (MODE == 2) ? 5632 : 512; constexpr int t1 = (MODE == 2) ? 0 : 8; constexpr bool swiglu = (MODE == 2);
                bf16_t* base = (bf16_t*)(ws + OFF1) + (size_t)row0 * ld1 + (u.pn - t1) * 128 + wc * 32 + 8 * fq;
#pragma unroll
                for (int ai = 0; ai < 2; ++ai)
#pragma unroll
                    for (int m = 0; m < 4; ++m) { bf16_t* rowp = base + (size_t)(ai * HALF + m * 16) * ld1;
                        float r[8];
#pragma unroll
                        for (int n = 0; n < 2; ++n)
#pragma unroll
                            for (int j = 0; j < 4; ++j) { const float x0 = acc[ai][0][m][n][j], x1 = acc[ai][1][m][n][j]; const float s = fast_sigmoid(x1); r[4 * n + j] = swiglu ? x0 * x1 * s : x0 * s; }
                        u32x4 w; w.x = cvt2(r[0], r[1]); w.y = cvt2(r[2], r[3]); w.z = cvt2(r[4], r[5]); w.w = cvt2(r[6], r[7]);
                        *(u32x4*)rowp = w; }
            } else {
                bf16_t* base; int ld, colt;
                if (MODE == 1) { base = (bf16_t*)(ws + OFF0); ld = 8192; colt = u.pn * BM; }
                else if (u.pn < 8) { base = (bf16_t*)(ws + OFF0); ld = 2048; colt = u.pn * BM; } else { base = (bf16_t*)(ws + OFF2); ld = 1024; colt = (u.pn - 12) * BM; }
                base += (size_t)row0 * ld + colt + wc * 32 + 8 * fq;
#pragma unroll
                for (int ai = 0; ai < 2; ++ai)
#pragma unroll
                    for (int m = 0; m < 4; ++m) { bf16_t* rowp = base + (size_t)(ai * HALF + m * 16) * ld;
#pragma unroll
                        for (int bj = 0; bj < 2; ++bj) { const f32x4 v0 = acc[ai][bj][m][0], v1 = acc[ai][bj][m][1];
                            u32x4 w; w.x = cvt2(v0[0], v0[1]); w.y = cvt2(v0[2], v0[3]); w.z = cvt2(v1[0], v1[1]); w.w = cvt2(v1[2], v1[3]);
                            *(u32x4*)(rowp + bj * HALF) = w; } }
            }
        }
    }
};
template <class Epi, class Sched, bool ALIGN_EPI = false, bool SP2 = false>
__device__ __forceinline__ void gemm_phase(PG8_LAS unsigned char* lds, const Gemm g, const Sched& S, const Epi& E) {
    const int tid = threadIdx.x, wid = __builtin_amdgcn_readfirstlane(tid >> 6), lane = tid & 63, wr = wid >> 2, wc = wid & 3, fr = lane & 15, fq = lane >> 4;
    const int K = g.K, nt = K / BK;
    unsigned voffA[2], voffB[2];
#pragma unroll
    for (int i = 0; i < 2; ++i) { int R, C; stage_rc(tid * 16 + i * 8192, R, C); const int Rb = Epi::PERM ? ((R & ~31) + perm32(R & 31)) : R;
        voffA[i] = (unsigned)(R * K + C) * 2u; voffB[i] = (unsigned)(Rb * K + C) * 2u; }
    const size_t kstep = (size_t)(BK * 2);
    const size_t hstep = (size_t)HALF * K * 2;
    const size_t tstep = 2 * hstep;
    const unsigned ldsw = (unsigned)wid * 1024u;
    const int aoff = lds_byte(wr * 64 + fr, fq * 8), boff = lds_byte(wc * 32 + fr, fq * 8);
#define PG8_SA(b, h) (((b) * 2 + (h)) * HTB)
#define PG8_SB(b, h) ((4 + (b) * 2 + (h)) * HTB)
#define PG8_STAGE(bufoff, gbase, voff) do { _Pragma("unroll") for (int _i = 0; _i < 2; ++_i) \
        __builtin_amdgcn_global_load_lds((const unsigned*)((const char*)(gbase) + (voff)[_i]), (PG8_LAS unsigned*)(lds + (bufoff) + ldsw + _i * 8192), 16, 0, 0); } while (0)
#define PG8_LDA(dst, b, h) do { _Pragma("unroll") for (int m = 0; m < 4; ++m) _Pragma("unroll") for (int k = 0; k < 2; ++k) dst[m][k] = *(const PG8_LAS bf16x8*)(lds + PG8_SA(b, h) + aoff + m * 2048 + k * 1024); } while (0)
#define PG8_LDB(dst, b, h) do { _Pragma("unroll") for (int n = 0; n < 2; ++n) _Pragma("unroll") for (int k = 0; k < 2; ++k) dst[n][k] = *(const PG8_LAS bf16x8*)(lds + PG8_SB(b, h) + boff + n * 2048 + k * 1024); } while (0)
#define PG8_MMA(ai, bj, At, Bt) do { __builtin_amdgcn_s_setprio(1); _Pragma("unroll") for (int m = 0; m < 4; ++m) _Pragma("unroll") for (int n = 0; n < 2; ++n) _Pragma("unroll") for (int k = 0; k < 2; ++k) \
        acc[ai][bj][m][n] = __builtin_amdgcn_mfma_f32_16x16x32_bf16(Bt[n][k], At[m][k], acc[ai][bj][m][n], 0, 0, 0); __builtin_amdgcn_s_setprio(0); } while (0)
#define PG8_WAIT_V(n) asm volatile("s_waitcnt vmcnt(" #n ")" ::: "memory")
#define PG8_WAIT_L(n) asm volatile("s_waitcnt lgkmcnt(" #n ")" ::: "memory")
#define PG8_BAR __builtin_amdgcn_s_barrier()
#define PG8_SCHED __builtin_amdgcn_sched_barrier(0)
    Unit cur, nxt; int ui = 0;
    if (!S.next(0, cur)) return;
    f32x4 acc[2][2][4][2];
#pragma unroll
    for (int a = 0; a < 2; ++a)
#pragma unroll
        for (int b = 0; b < 2; ++b)
#pragma unroll
            for (int m = 0; m < 4; ++m)
#pragma unroll
                for (int n = 0; n < 2; ++n) acc[a][b][m][n] = (f32x4){0.f, 0.f, 0.f, 0.f};
    bf16x8 At[4][2], B0[2][2], B1[2][2];
    const char* cA = (const char*)g.A + (size_t)cur.pm * tstep; const char* cB = (const char*)g.Bt + (size_t)cur.pn * tstep;
    S.a_ready(cur);
    if constexpr (SP2) {
        PG8_STAGE(PG8_SB(0, 0), cB, voffB); PG8_STAGE(PG8_SB(0, 1), cB + hstep, voffB); PG8_STAGE(PG8_SA(0, 0), cA, voffA); PG8_STAGE(PG8_SA(0, 1), cA + hstep, voffA);
        if (wr == 1) PG8_BAR;
        PG8_WAIT_V(2); PG8_BAR;
        PG8_STAGE(PG8_SB(1, 0), cB + kstep, voffB); PG8_STAGE(PG8_SA(1, 0), cA + kstep, voffA); PG8_STAGE(PG8_SB(1, 1), cB + hstep + kstep, voffB);
        PG8_WAIT_V(6); PG8_BAR;
    } else {
        PG8_STAGE(PG8_SB(0, 0), cB, voffB); PG8_STAGE(PG8_SA(0, 0), cA, voffA); PG8_STAGE(PG8_SB(0, 1), cB + hstep, voffB); PG8_STAGE(PG8_SA(0, 1), cA + hstep, voffA);
        if (wr == 1) PG8_BAR;
        PG8_WAIT_V(4); PG8_BAR;
        PG8_STAGE(PG8_SB(1, 0), cB + kstep, voffB); PG8_STAGE(PG8_SA(1, 0), cA + kstep, voffA); PG8_STAGE(PG8_SB(1, 1), cB + hstep + kstep, voffB);
        PG8_WAIT_V(6); PG8_BAR;
    }
    for (;;) {
        const bool has_next = S.next(ui + 1, nxt);
        const char* nA = has_next ? (const char*)g.A + (size_t)nxt.pm * tstep : cA; const char* nB = has_next ? (const char*)g.Bt + (size_t)nxt.pn * tstep : cB;
        for (int t = 0; t < nt; t += 2) {
            const bool last = (t == nt - 2);
            const char* a1 = cA + (size_t)(t + 1) * kstep;
            const char* a2 = last ? nA : cA + (size_t)(t + 2) * kstep; const char* b2 = last ? nB : cB + (size_t)(t + 2) * kstep;
            const char* a3 = a2 + kstep; const char* b3 = b2 + kstep;
            if (last && has_next) S.a_ready(nxt);
            if constexpr (SP2) {
            PG8_LDB(B0, 0, 0); PG8_LDB(B1, 0, 1); PG8_SCHED; PG8_LDA(At, 0, 0); PG8_STAGE(PG8_SA(1, 1), a1 + hstep, voffA);
            PG8_WAIT_V(8); PG8_WAIT_L(0); PG8_BAR; PG8_MMA(0, 0, At, B0); PG8_MMA(0, 1, At, B1); PG8_BAR; PG8_SCHED;
            PG8_LDA(At, 0, 1); PG8_STAGE(PG8_SB(0, 0), b2, voffB); PG8_STAGE(PG8_SB(0, 1), b2 + hstep, voffB); PG8_STAGE(PG8_SA(0, 0), a2, voffA);
            PG8_WAIT_V(8); PG8_WAIT_L(0); PG8_BAR; PG8_MMA(1, 0, At, B0); PG8_MMA(1, 1, At, B1); PG8_BAR; PG8_SCHED;
            PG8_LDB(B0, 1, 0); PG8_LDB(B1, 1, 1); PG8_SCHED; PG8_LDA(At, 1, 0); PG8_STAGE(PG8_SA(0, 1), a2 + hstep, voffA);
            PG8_WAIT_V(8); PG8_WAIT_L(0); PG8_BAR; PG8_MMA(0, 0, At, B0); PG8_MMA(0, 1, At, B1); PG8_BAR; PG8_SCHED;
            PG8_LDA(At, 1, 1); PG8_STAGE(PG8_SB(1, 0), b3, voffB); PG8_STAGE(PG8_SB(1, 1), b3 + hstep, voffB); PG8_STAGE(PG8_SA(1, 0), a3, voffA);
            PG8_WAIT_V(8); PG8_WAIT_L(0); PG8_BAR; PG8_MMA(1, 0, At, B0); PG8_MMA(1, 1, At, B1); PG8_BAR; PG8_SCHED;
            } else {
            PG8_LDB(B0, 0, 0); PG8_SCHED; PG8_LDA(At, 0, 0); PG8_STAGE(PG8_SA(1, 1), a1 + hstep, voffA);
            PG8_WAIT_L(8); PG8_BAR; PG8_WAIT_L(0); PG8_MMA(0, 0, At, B0); PG8_BAR; PG8_SCHED;
            PG8_LDB(B1, 0, 1); PG8_STAGE(PG8_SB(0, 0), b2, voffB);
            PG8_BAR; PG8_WAIT_L(0); PG8_MMA(0, 1, At, B1); PG8_BAR;
            PG8_LDA(At, 0, 1); PG8_STAGE(PG8_SA(0, 0), a2, voffA);
            PG8_BAR; PG8_WAIT_L(0); PG8_MMA(1, 0, At, B0); PG8_BAR; PG8_SCHED;
            PG8_STAGE(PG8_SB(0, 1), b2 + hstep, voffB);
            PG8_WAIT_V(6); PG8_BAR; PG8_MMA(1, 1, At, B1); PG8_BAR;
            PG8_LDB(B0, 1, 0); PG8_SCHED; PG8_LDA(At, 1, 0); PG8_STAGE(PG8_SA(0, 1), a2 + hstep, voffA);
            PG8_WAIT_L(8); PG8_BAR; PG8_WAIT_L(0); PG8_MMA(0, 0, At, B0); PG8_BAR; PG8_SCHED;
            PG8_LDB(B1, 1, 1); PG8_STAGE(PG8_SB(1, 0), b3, voffB);
            PG8_BAR; PG8_WAIT_L(0); PG8_MMA(0, 1, At, B1); PG8_BAR;
            PG8_LDA(At, 1, 1); PG8_STAGE(PG8_SA(1, 0), a3, voffA);
            PG8_BAR; PG8_WAIT_L(0); PG8_MMA(1, 0, At, B0); PG8_BAR; PG8_SCHED;
            PG8_STAGE(PG8_SB(1, 1), b3 + hstep, voffB);
            PG8_WAIT_V(6); PG8_BAR; PG8_MMA(1, 1, At, B1); PG8_BAR;
            }
        }
        if constexpr (ALIGN_EPI) { if (wr == 0) PG8_BAR; }
        if constexpr (!Epi::AFTER_DRAIN) { E(acc, cur, wr, wc, fr, fq); S.done(cur); }
        if (!has_next) break;
#pragma unroll
        for (int a = 0; a < 2; ++a)
#pragma unroll
            for (int b = 0; b < 2; ++b)
#pragma unroll
                for (int m = 0; m < 4; ++m)
#pragma unroll
                    for (int n = 0; n < 2; ++n) acc[a][b][m][n] = (f32x4){0.f, 0.f, 0.f, 0.f};
        cur = nxt; cA = nA; cB = nB; ++ui;
        if constexpr (ALIGN_EPI) { if (wr == 1) PG8_BAR; }
    }
    PG8_WAIT_V(0);
    if constexpr (!ALIGN_EPI) { if (wr == 0) PG8_BAR; }
    PG8_BAR;
    if constexpr (Epi::AFTER_DRAIN) { E.fused(acc, cur, wr, wc, fr, fq, lds, wid, lane); S.done(cur); }
#undef PG8_SA
#undef PG8_SB
#undef PG8_STAGE
#undef PG8_LDA
#undef PG8_LDB
#undef PG8_MMA
#undef PG8_WAIT_V
#undef PG8_WAIT_L
#undef PG8_BAR
#undef PG8_SCHED
}
}

constexpr int DM = 2048, NB = 4, SEQ = 2048, DEPTH = 4, MTOK = NB * SEQ;
constexpr int INCOLS = 5120, DFF = 5632, NGU = 2 * DFF;
constexpr float EPS = 1e-6f;
constexpr int NWAVES = 8, NTHREADS = 512;
constexpr int LDS_BYTES = 147456;

constexpr size_t MiB = 1u << 20;
constexpr size_t WS_CTL = 0, CTL_BYTES = 16384;
constexpr size_t WS_U = 1 * MiB, WS_QK = 33 * MiB, WS_VT = 65 * MiB, WS_UGLU = 81 * MiB, WS_RXY = 89 * MiB, WS_MIXED = 105 * MiB;
constexpr size_t WS_HLOC = 137 * MiB, WS_ACUM = 153 * MiB, WS_SUM = 169 * MiB, WS_O = 170 * MiB, WS_F = 234 * MiB, WS_W = 322 * MiB;
constexpr size_t WL_MAIN = 0, WL_V = 16 * MiB, WL_OUT = 20 * MiB, WL_GU = 28 * MiB, WL_DOWN = 72 * MiB, WL_LRU = 94 * MiB, WL_STRIDE = 95 * MiB;
constexpr size_t WS_END = WS_W + 4 * WL_STRIDE;

#define LAS __attribute__((address_space(3)))
#define DI __device__ __forceinline__
typedef unsigned short bf16;
typedef short bf16x8 __attribute__((ext_vector_type(8)));
typedef float f32x4 __attribute__((ext_vector_type(4)));
typedef float f32x16 __attribute__((ext_vector_type(16)));
typedef unsigned u32x2 __attribute__((ext_vector_type(2)));
typedef unsigned u32x4 __attribute__((ext_vector_type(4)));
#define MFMA32(a, b, c) __builtin_amdgcn_mfma_f32_32x32x16_bf16((a), (b), (c), 0, 0, 0)

DI unsigned pk2(float lo, float hi) { return pg8::cvt2(lo, hi); }
DI float bf2f(unsigned short b) { return __uint_as_float(((unsigned)b) << 16); }
DI float bflo(unsigned w) { return __uint_as_float(w << 16); }
DI float bfhi(unsigned w) { return __uint_as_float(w & 0xffff0000u); }
DI float sigm(float x) { return __builtin_amdgcn_rcpf(1.0f + __expf(-x)); }
DI float wave_sum(float v) {
#pragma unroll
    for (int o = 1; o < 64; o <<= 1) v += __shfl_xor(v, o);
    return v;
}
#define LDS_WAIT() asm volatile("s_waitcnt lgkmcnt(0)" ::: "memory")

struct Args { const float* in[24]; float* out; unsigned char* ws; };

DI void tr_item(const float* __restrict__ src, int pitch, int col0, int k0, const float* __restrict__ gain, bf16* __restrict__ dst, int dpitch, int drow0, LAS float* scr, int lane) {
#pragma unroll 8
    for (int kk = 0; kk < 64; ++kk) scr[kk * 65 + lane] = src[(size_t)(k0 + kk) * pitch + col0 + lane];
    LDS_WAIT();
    const int c = lane & 7;
    float g[8];
#pragma unroll
    for (int j = 0; j < 8; ++j) g[j] = gain ? gain[k0 + 8 * c + j] : 1.0f;
#pragma unroll
    for (int jj = 0; jj < 8; ++jj) { const int n = (lane >> 3) + 8 * jj; const LAS float* s = scr + (8 * c) * 65 + n;
        u32x4 o; o.x = pk2(s[0] * g[0], s[65] * g[1]); o.y = pk2(s[2 * 65] * g[2], s[3 * 65] * g[3]); o.z = pk2(s[4 * 65] * g[4], s[5 * 65] * g[5]); o.w = pk2(s[6 * 65] * g[6], s[7 * 65] * g[7]);
        *(u32x4*)(dst + (size_t)(drow0 + n) * dpitch + k0 + 8 * c) = o; }
    LDS_WAIT();
}
constexpr int IT_MAIN = 32 * 64, IT_V = 32 * 16, IT_OUT = 32 * 32, IT_GU = 32 * 176, IT_DOWN = 88 * 32, IT_LRU = 32;
constexpr int IT_LAYER = IT_MAIN + IT_V + IT_OUT + IT_GU + IT_DOWN + IT_LRU;
DI void convert_item(const __attribute__((address_space(4))) Args* ap, int it, LAS float* scr, int lane) {
    const int l = it / IT_LAYER; int idx = it % IT_LAYER;
    unsigned char* wl = ap->ws + WS_W + (size_t)l * WL_STRIDE;
    if (idx < IT_MAIN) { const int kb = idx / 64, nb = idx % 64, drow0 = nb * 64, pn = drow0 / 256, w = drow0 % 256;
        const int col0 = pn < 8 ? drow0 : (pn < 12 ? (w < 128 ? 3072 + 128 * (pn - 8) + w : 3584 + 128 * (pn - 8) + (w - 128)) : drow0 + 1024);
        tr_item(ap->in[1] + (size_t)l * DM * INCOLS, INCOLS, col0, kb * 64, ap->in[3] + l * DM, (bf16*)(wl + WL_MAIN), DM, drow0, scr, lane); return; }
    idx -= IT_MAIN;
    if (idx < IT_V) { const int kb = idx / 16, nb = idx % 16;
        tr_item(ap->in[1] + (size_t)l * DM * INCOLS, INCOLS, 2048 + nb * 64, kb * 64, ap->in[3] + l * DM, (bf16*)(wl + WL_V), DM, nb * 64, scr, lane); return; }
    idx -= IT_V;
    if (idx < IT_OUT) { const int kb = idx / 32, nb = idx % 32, k0 = kb * 64;
        const float* g = k0 < 1024 ? ap->in[7] + l * 1024 : (k0 < 1536 ? ap->in[8] + l * 512 - 1024 : ap->in[9] + l * 512 - 1536);
        tr_item(ap->in[2] + (size_t)l * DM * DM, DM, nb * 64, k0, g, (bf16*)(wl + WL_OUT), DM, nb * 64, scr, lane); return; }
    idx -= IT_OUT;
    if (idx < IT_GU) { const int kb = idx / 176, nb = idx % 176, drow0 = nb * 64, pn = drow0 / 256, w = drow0 % 256;
        const float* src = (w < 128 ? ap->in[22] : ap->in[21]) + (size_t)l * DM * DFF; const int col0 = 128 * pn + (w & 127);
        tr_item(src, DFF, col0, kb * 64, ap->in[5] + l * DM, (bf16*)(wl + WL_GU), DM, drow0, scr, lane); return; }
    idx -= IT_GU;
    if (idx < IT_DOWN) { const int kb = idx / 32, nb = idx % 32;
        tr_item(ap->in[23] + (size_t)l * DFF * DM, DM, nb * 64, kb * 64, nullptr, (bf16*)(wl + WL_DOWN), DFF, nb * 64, scr, lane); return; }
    idx -= IT_DOWN;
    { const int gate = idx >> 4, n = (idx >> 2) & 3, kb = (idx >> 1) & 1, nb = idx & 1;
        const float* src = (gate ? ap->in[18] : ap->in[16]) + (size_t)l * 4 * 128 * 128 + (size_t)n * 128 * 128;
        tr_item(src, 128, nb * 64, kb * 64, nullptr, (bf16*)(wl + WL_LRU) + (size_t)(gate * 4 + n) * 128 * 128, 128, nb * 64, scr, lane); }
}

DI void row_init(const float* __restrict__ x, float* __restrict__ h, bf16* __restrict__ u, int gw, int ngw, int lane) {
    for (int m = gw; m < MTOK; m += ngw) {
        const f32x4* xr = (const f32x4*)(x + (size_t)m * DM) + lane; f32x4 v[8]; float ss = 0.f;
#pragma unroll
        for (int j = 0; j < 8; ++j) { v[j] = xr[64 * j]; ss += (v[j].x * v[j].x + v[j].y * v[j].y) + (v[j].z * v[j].z + v[j].w * v[j].w); }
        const float r = rsqrtf(wave_sum(ss) * (1.0f / DM) + EPS);
        f32x4* hr = (f32x4*)(h + (size_t)m * DM) + lane; u32x2* ur = (u32x2*)(u + (size_t)m * DM) + lane;
#pragma unroll
        for (int j = 0; j < 8; ++j) { hr[64 * j] = v[j]; u32x2 w; w.x = pk2(v[j].x * r, v[j].y * r); w.y = pk2(v[j].z * r, v[j].w * r); ur[64 * j] = w; }
    }
}
DI void row_res(const float* __restrict__ o, const float* __restrict__ g, float* __restrict__ h, bf16* __restrict__ u, bool write_u, int gw, int ngw, int lane) {
    for (int m = gw; m < MTOK; m += ngw) {
        const f32x4* orow = (const f32x4*)(o + (size_t)m * DM) + lane; f32x4 v[8]; float ss = 0.f;
#pragma unroll
        for (int j = 0; j < 8; ++j) { v[j] = orow[64 * j]; ss += (v[j].x * v[j].x + v[j].y * v[j].y) + (v[j].z * v[j].z + v[j].w * v[j].w); }
        const float r = rsqrtf(wave_sum(ss) * (1.0f / DM) + EPS);
        f32x4* hr = (f32x4*)(h + (size_t)m * DM) + lane; const f32x4* gr = (const f32x4*)g + lane; float s2 = 0.f;
#pragma unroll
        for (int j = 0; j < 8; ++j) { const f32x4 hv = hr[64 * j], gv = gr[64 * j]; v[j] = hv + v[j] * r * gv; hr[64 * j] = v[j]; s2 += (v[j].x * v[j].x + v[j].y * v[j].y) + (v[j].z * v[j].z + v[j].w * v[j].w); }
        if (write_u) { const float r2 = rsqrtf(wave_sum(s2) * (1.0f / DM) + EPS); u32x2* ur = (u32x2*)(u + (size_t)m * DM) + lane;
#pragma unroll
            for (int j = 0; j < 8; ++j) { u32x2 w; w.x = pk2(v[j].x * r2, v[j].y * r2); w.y = pk2(v[j].z * r2, v[j].w * r2); ur[64 * j] = w; } }
    }
}

DI void attn_unit(const bf16* __restrict__ QK, const bf16* __restrict__ VT, bf16* __restrict__ mixed, int b, int qt, LAS float* red, int wave, int lane) {
    const int n = lane & 31, hh = lane >> 5, h = wave;
    const int qpos = qt * 32 + n; const size_t tokq = (size_t)b * SEQ + qpos;
    const bf16* qp = QK + tokq * 2048 + h * 128 + 8 * hh;
    bf16x8 qf[8];
#pragma unroll
    for (int s = 0; s < 8; ++s) qf[s] = *(const bf16x8*)(qp + 16 * s);
    f32x16 o[4];
#pragma unroll
    for (int d = 0; d < 4; ++d)
#pragma unroll
        for (int i = 0; i < 16; ++i) o[d][i] = 0.f;
    float R = 0.f;
    const float scale = 0.08838834764831845f;
    for (int kt = qt; kt >= 0; --kt) {
        const int key0 = kt * 32;
        const bf16* kp = QK + ((size_t)b * SEQ + key0 + n) * 2048 + 1024 + h * 128 + 8 * hh;
        f32x16 s;
#pragma unroll
        for (int i = 0; i < 16; ++i) s[i] = 0.f;
#pragma unroll
        for (int st = 0; st < 8; ++st) { const bf16x8 kf = *(const bf16x8*)(kp + 16 * st); s = MFMA32(kf, qf[st], s); }
        float lk[16], lw[16];
#pragma unroll
        for (int i = 0; i < 16; ++i) { const float z = s[i] * scale; const int kpos = key0 + 8 * (i >> 2) + 4 * hh + (i & 3);
            const float sp = fmaxf(z, 0.f) + __logf(1.0f + __expf(-fabsf(z)));
            lk[i] = (kpos < qpos) ? -sp : 0.f; lw[i] = (kpos < qpos) ? (z - sp) : -1.0e30f; }
        float gt[4], og[4];
#pragma unroll
        for (int c = 0; c < 4; ++c) { gt[c] = (lk[4 * c] + lk[4 * c + 1]) + (lk[4 * c + 2] + lk[4 * c + 3]); og[c] = __shfl_xor(gt[c], 32); }
        float run = R; float w[16];
#pragma unroll
        for (int c = 3; c >= 0; --c) {
            const float c3 = run + (hh == 0 ? og[c] : 0.f), c2 = c3 + lk[4 * c + 3], c1 = c2 + lk[4 * c + 2], c0 = c1 + lk[4 * c + 1];
            w[4 * c + 3] = __expf(lw[4 * c + 3] + c3); w[4 * c + 2] = __expf(lw[4 * c + 2] + c2); w[4 * c + 1] = __expf(lw[4 * c + 1] + c1); w[4 * c] = __expf(lw[4 * c] + c0);
            run += gt[c] + og[c];
        }
        R = run;
        const bf16* vbase = VT + (size_t)(h * 128 + n) * MTOK + (size_t)b * SEQ + key0 + 4 * hh;
#pragma unroll
        for (int ks = 0; ks < 2; ++ks) {
            u32x4 p; p.x = pk2(w[8 * ks], w[8 * ks + 1]); p.y = pk2(w[8 * ks + 2], w[8 * ks + 3]); p.z = pk2(w[8 * ks + 4], w[8 * ks + 5]); p.w = pk2(w[8 * ks + 6], w[8 * ks + 7]);
            const bf16x8 pf = __builtin_bit_cast(bf16x8, p);
#pragma unroll
            for (int dt = 0; dt < 4; ++dt) { const bf16* vp = vbase + (size_t)(32 * dt) * MTOK + 16 * ks;
                const u32x2 lo = *(const u32x2*)vp, hi = *(const u32x2*)(vp + 8); u32x4 vv; vv.x = lo.x; vv.y = lo.y; vv.z = hi.x; vv.w = hi.y;
                o[dt] = MFMA32(__builtin_bit_cast(bf16x8, vv), pf, o[dt]); }
        }
        if (__all(R < -110.0f)) break;
    }
    float ss = 0.f;
#pragma unroll
    for (int d = 0; d < 4; ++d)
#pragma unroll
        for (int i = 0; i < 16; ++i) ss += o[d][i] * o[d][i];
    ss += __shfl_xor(ss, 32);
    if (hh == 0) red[wave * 32 + n] = ss;
    __syncthreads();
    float tot = 0.f;
#pragma unroll
    for (int w8 = 0; w8 < 8; ++w8) tot += red[w8 * 32 + n];
    const float r = rsqrtf(tot * (1.0f / 1024.0f) + EPS);
    bf16* op = mixed + tokq * 2048 + h * 128 + 4 * hh;
#pragma unroll
    for (int dt = 0; dt < 4; ++dt)
#pragma unroll
        for (int c = 0; c < 4; ++c) { u32x2 wv; wv.x = pk2(o[dt][4 * c] * r, o[dt][4 * c + 1] * r); wv.y = pk2(o[dt][4 * c + 2] * r, o[dt][4 * c + 3] * r);
            *(u32x2*)(op + 32 * dt + 8 * c) = wv; }
    __syncthreads();
}

DI void conv_unit(const bf16* __restrict__ UGLU, const float* __restrict__ dww, const float* __restrict__ dwb, const float* __restrict__ lng, const float* __restrict__ lnb,
                  bf16* __restrict__ mixed, int t0, LAS unsigned char* lds, int tid, int wave, int lane) {
    LAS bf16* Xin = (LAS bf16*)lds;
    LAS float* Y = (LAS float*)(lds + 63488);
    const int bstart = (t0 / SEQ) * SEQ;
    for (int r = wave; r < 62; r += 8) { const int tok = t0 - 30 + r; u32x4 v = {0u, 0u, 0u, 0u};
        if (tok >= bstart) v = *(const u32x4*)(UGLU + (size_t)tok * 512 + lane * 8);
        *(LAS u32x4*)(Xin + r * 512 + lane * 8) = v; }
    __syncthreads();
    const int c = tid;
    float in[62];
#pragma unroll
    for (int r = 0; r < 62; ++r) in[r] = bf2f(Xin[r * 512 + c]);
    float acc[32]; const float bias = dwb[c];
#pragma unroll
    for (int t = 0; t < 32; ++t) acc[t] = bias;
#pragma unroll
    for (int j = 0; j < 31; ++j) { const float wj = dww[j * 512 + c];
#pragma unroll
        for (int t = 0; t < 32; ++t) acc[t] += wj * in[t + j]; }
#pragma unroll
    for (int t = 0; t < 32; ++t) Y[t * 512 + c] = acc[t];
    __syncthreads();
    const f32x4 g0 = *(const f32x4*)(lng + 4 * lane), g1 = *(const f32x4*)(lng + 256 + 4 * lane), b0 = *(const f32x4*)(lnb + 4 * lane), b1 = *(const f32x4*)(lnb + 256 + 4 * lane);
    for (int t = wave; t < 32; t += 8) {
        f32x4 v0 = *(const LAS f32x4*)(Y + t * 512 + 4 * lane), v1 = *(const LAS f32x4*)(Y + t * 512 + 256 + 4 * lane);
        const float mean = wave_sum((v0.x + v0.y) + (v0.z + v0.w) + (v1.x + v1.y) + (v1.z + v1.w)) * (1.0f / 512.0f);
        v0 = v0 - mean; v1 = v1 - mean;
        const float var = wave_sum((v0.x * v0.x + v0.y * v0.y) + (v0.z * v0.z + v0.w * v0.w) + (v1.x * v1.x + v1.y * v1.y) + (v1.z * v1.z + v1.w * v1.w)) * (1.0f / 512.0f);
        const float rs = rsqrtf(var + EPS);
        v0 = v0 * rs * g0 + b0; v1 = v1 * rs * g1 + b1;
        float ss = 0.f;
#pragma unroll
        for (int e = 0; e < 4; ++e) { v0[e] = v0[e] * sigm(v0[e]); v1[e] = v1[e] * sigm(v1[e]); ss += v0[e] * v0[e] + v1[e] * v1[e]; }
        const float r2 = rsqrtf(wave_sum(ss) * (1.0f / 512.0f) + EPS);
        bf16* op = mixed + (size_t)(t0 + t) * 2048 + 1024 + 4 * lane;
        u32x2 w0, w1; w0.x = pk2(v0.x * r2, v0.y * r2); w0.y = pk2(v0.z * r2, v0.w * r2); w1.x = pk2(v1.x * r2, v1.y * r2); w1.y = pk2(v1.z * r2, v1.w * r2);
        *(u32x2*)op = w0; *(u32x2*)(op + 256) = w1;
    }
    __syncthreads();
}

DI void lru1_unit(const bf16* __restrict__ RXY, const float* __restrict__ cw, const float* __restrict__ cb, const bf16* __restrict__ Wl, const float* __restrict__ ba, const float* __restrict__ bi,
                  const float* __restrict__ lam, float* __restrict__ HLOC, float* __restrict__ ACUM, float* __restrict__ SUMA, float* __restrict__ SUMH, int t0, LAS unsigned char* lds, int tid, int wave, int lane) {
    constexpr int XP = 520;
    LAS bf16* X = (LAS bf16*)lds;
    const int bstart = (t0 / SEQ) * SEQ;
    { const int c = tid; const float w0 = cw[c], w1 = cw[512 + c], w2 = cw[1024 + c], w3 = cw[1536 + c], bb = cb[c];
        float x[35];
#pragma unroll
        for (int r = 0; r < 35; ++r) { const int tok = t0 - 3 + r; x[r] = (tok >= bstart) ? bf2f(RXY[(size_t)tok * 1024 + c]) : 0.f; }
#pragma unroll
        for (int t = 0; t < 32; ++t) { const float xr = bb + (w0 * x[t] + w1 * x[t + 1]) + (w2 * x[t + 2] + w3 * x[t + 3]); X[t * XP + c] = (bf16)(pk2(xr, 0.f) & 0xffffu); } }
    __syncthreads();
    const int n = wave >> 1, half = wave & 1, tl = lane & 31, hh = lane >> 5;
    f32x16 acc[2][2];
#pragma unroll
    for (int g = 0; g < 2; ++g)
#pragma unroll
        for (int mt = 0; mt < 2; ++mt)
#pragma unroll
            for (int i = 0; i < 16; ++i) acc[g][mt][i] = 0.f;
#pragma unroll
    for (int s = 0; s < 8; ++s) { const bf16x8 bfr = *(const LAS bf16x8*)(X + tl * XP + 128 * n + 16 * s + 8 * hh);
#pragma unroll
        for (int g = 0; g < 2; ++g)
#pragma unroll
            for (int mt = 0; mt < 2; ++mt) { const bf16* wp = Wl + ((size_t)(g * 4 + n) * 128 + 64 * half + 32 * mt + tl) * 128 + 16 * s + 8 * hh;
                acc[g][mt] = MFMA32(*(const bf16x8*)wp, bfr, acc[g][mt]); } }
    const int chunk = t0 / 32;
#pragma unroll
    for (int mt = 0; mt < 2; ++mt)
#pragma unroll
        for (int cg4 = 0; cg4 < 4; ++cg4) {
            const int ch0 = 128 * n + 64 * half + 32 * mt + 8 * cg4 + 4 * hh;
            const u32x2 xw = *(const LAS u32x2*)(X + tl * XP + ch0);
            const float xr[4] = {bflo(xw.x), bfhi(xw.x), bflo(xw.y), bfhi(xw.y)};
            const f32x4 ba4 = *(const f32x4*)(ba + ch0), bi4 = *(const f32x4*)(bi + ch0), lam4 = *(const f32x4*)(lam + ch0);
            float av[4], bv[4];
#pragma unroll
            for (int e = 0; e < 4; ++e) { const int i = 4 * cg4 + e;
                const float r = sigm(acc[0][mt][i] + ba4[e]), ig = sigm(acc[1][mt][i] + bi4[e]);
                const float sp = log1pf(expf(-lam4[e]));
                const float la = -8.0f * r * sp;
                av[e] = expf(la); bv[e] = sqrtf(-expm1f(2.0f * la)) * (ig * xr[e]); }
#pragma unroll
            for (int d = 1; d < 32; d <<= 1)
#pragma unroll
                for (int e = 0; e < 4; ++e) { const float ap = __shfl_up(av[e], d, 32), bp = __shfl_up(bv[e], d, 32);
                    if (tl >= d) { bv[e] = av[e] * bp + bv[e]; av[e] = av[e] * ap; } }
            const size_t off = (size_t)(t0 + tl) * 512 + ch0;
            *(f32x4*)(HLOC + off) = (f32x4){bv[0], bv[1], bv[2], bv[3]};
            *(f32x4*)(ACUM + off) = (f32x4){av[0], av[1], av[2], av[3]};
            if (tl == 31) { *(f32x4*)(SUMA + (size_t)chunk * 512 + ch0) = (f32x4){av[0], av[1], av[2], av[3]}; *(f32x4*)(SUMH + (size_t)chunk * 512 + ch0) = (f32x4){bv[0], bv[1], bv[2], bv[3]}; }
        }
    __syncthreads();
}

DI void lru2_unit(const bf16* __restrict__ RXY, const float* __restrict__ HLOC, const float* __restrict__ ACUM, const float* __restrict__ SUMA, const float* __restrict__ SUMH,
                  bf16* __restrict__ mixed, int t0, LAS unsigned char* lds, int tid, int wave, int lane) {
    LAS float* carry = (LAS float*)lds;
    const int b = t0 / SEQ, cidx = (t0 % SEQ) / 32;
    { const float* sa = SUMA + (size_t)(b * 64) * 512 + tid; const float* sh = SUMH + (size_t)(b * 64) * 512 + tid; float cr = 0.f;
#pragma unroll 4
        for (int k = 0; k < cidx; ++k) cr = sa[(size_t)k * 512] * cr + sh[(size_t)k * 512];
        carry[tid] = cr; }
    __syncthreads();
    for (int t = wave; t < 32; t += 8) { const size_t tok = (size_t)t0 + t; float y[8]; float ss = 0.f;
#pragma unroll
        for (int jj = 0; jj < 2; ++jj) { const int ch = 4 * lane + 256 * jj;
            const f32x4 hl = *(const f32x4*)(HLOC + tok * 512 + ch), ac = *(const f32x4*)(ACUM + tok * 512 + ch), cr = *(const LAS f32x4*)(carry + ch);
            const u32x2 rw = *(const u32x2*)(RXY + tok * 1024 + 512 + ch); const float ry[4] = {bflo(rw.x), bfhi(rw.x), bflo(rw.y), bfhi(rw.y)};
#pragma unroll
            for (int e = 0; e < 4; ++e) { const float hv = hl[e] + ac[e] * cr[e]; const float x = ry[e];
                const float u2 = 1.5957691216057308f * (x + 0.044715f * x * x * x);
                const float yv = hv * (x * sigm(u2)); y[4 * jj + e] = yv; ss += yv * yv; } }
        const float r = rsqrtf(wave_sum(ss) * (1.0f / 512.0f) + EPS);
        bf16* op = mixed + tok * 2048 + 1536 + 4 * lane;
        u32x2 w0, w1; w0.x = pk2(y[0] * r, y[1] * r); w0.y = pk2(y[2] * r, y[3] * r); w1.x = pk2(y[4] * r, y[5] * r); w1.y = pk2(y[6] * r, y[7] * r);
        *(u32x2*)op = w0; *(u32x2*)(op + 256) = w1;
    }
    __syncthreads();
}

#define RLX_AGENT __ATOMIC_RELAXED, __HIP_MEMORY_SCOPE_AGENT
#define VM_WAIT() asm volatile("s_waitcnt vmcnt(0)" ::: "memory")
#define XB_TMO      128
#define XB_XCNT(j)  (256  + 64 * (j))
#define XB_XSUB(j)  (1280 + 64 * (j))
#define XB_XGEN(j)  (2304 + 64 * (j))
#define XB_TOP      3328
#define XB_TOPGEN   3392
#define XCD_BAR_WORDS 3456
#define XB_SPIN_CAP (1u << 18)

__device__ __forceinline__ unsigned xb_ld(unsigned* p)              { return __hip_atomic_load(p, __ATOMIC_RELAXED, __HIP_MEMORY_SCOPE_AGENT); }
__device__ __forceinline__ unsigned xb_add(unsigned* p, unsigned v) { return __hip_atomic_fetch_add(p, v, __ATOMIC_RELAXED, __HIP_MEMORY_SCOPE_AGENT); }
__device__ __forceinline__ unsigned xb_xcc_id() { return (unsigned)__builtin_amdgcn_s_getreg((3 << 11) | 20) & 0xFu; }
#define XB_SPIN(cond, bar) do { unsigned _sp = 0; while (cond) { __builtin_amdgcn_s_sleep(1); \
    if ((++_sp & 255u) == 0u) { if (xb_ld(&(bar)[XB_TMO])) break; if (_sp > XB_SPIN_CAP) { atomicAdd(&(bar)[XB_TMO], 1u); break; } } } } while (0)

struct XcdBarrier {
    unsigned* bar; unsigned x;
    volatile LAS unsigned* st;
};

__device__ __forceinline__ XcdBarrier xcd_barrier_post(unsigned* bar, volatile LAS unsigned* st) {
    XcdBarrier b; b.bar = bar; b.x = xb_xcc_id(); b.st = st;
    if (threadIdx.x == 0) (void)xb_add(&bar[XB_XCNT(b.x)], 1u);
    return b;
}
__device__ __forceinline__ void xcd_barrier_complete(unsigned* bar, unsigned x, unsigned& nloc, unsigned& nx) {
    const unsigned G = gridDim.x * gridDim.y * gridDim.z;
    unsigned sum, cnt, mine, sp = 0u;
    for (;;) {
        sum = 0u; cnt = 0u; mine = 0u;
#pragma unroll
        for (unsigned j = 0; j < 16; ++j) { const unsigned c = xb_ld(&bar[XB_XCNT(j)]); sum += c; cnt += (c > 0u) ? 1u : 0u; mine = (j == x) ? c : mine; }
        if (sum == G) break;
        __builtin_amdgcn_s_sleep(1);
        if ((++sp & 255u) == 0u) { if (xb_ld(&bar[XB_TMO])) break; if (sp > XB_SPIN_CAP) { atomicAdd(&bar[XB_TMO], 1u); break; } }
    }
    nloc = mine > 0u ? mine : 1u; nx = cnt > 0u ? cnt : 1u;
}

__device__ __forceinline__ void xcd_barrier(const XcdBarrier& b) {
    asm volatile("s_waitcnt vmcnt(0)" ::: "memory");
    __syncthreads();
    if (threadIdx.x == 0) {
        unsigned* bar = b.bar;
        __builtin_amdgcn_s_waitcnt(0);
        unsigned nloc = b.st[0], nx = b.st[1];
        if (nloc == 0u) { xcd_barrier_complete(bar, b.x, nloc, nx); b.st[0] = nloc; b.st[1] = nx; }
        const unsigned old = xb_add(&bar[XB_XSUB(b.x)], 1u);
        const unsigned gen = old / nloc;
        if (old + 1u == (gen + 1u) * nloc) {
            __builtin_amdgcn_fence(__ATOMIC_RELEASE, "agent");
            asm volatile("s_waitcnt vmcnt(0)" ::: "memory");
            const unsigned og = xb_add(&bar[XB_TOP], 1u);
            const unsigned tg = og / nx;
            if (og + 1u == (tg + 1u) * nx) xb_add(&bar[XB_TOPGEN], 1u);
            else XB_SPIN(xb_ld(&bar[XB_TOPGEN]) == tg, bar);
            __builtin_amdgcn_fence(__ATOMIC_ACQUIRE, "agent");
            xb_add(&bar[XB_XGEN(b.x)], 1u);
            asm volatile("s_waitcnt vmcnt(0)" ::: "memory");
        } else {
            XB_SPIN(xb_ld(&bar[XB_XGEN(b.x)]) == gen, bar);
            __builtin_amdgcn_fence(__ATOMIC_ACQUIRE, "agent");
            asm volatile("s_waitcnt vmcnt(0)" ::: "memory");
        }
    }
    __syncthreads();
}

#ifdef SKIP_GEMM
#define GEMMCALL if (0)
#else
#define GEMMCALL
#endif
#ifdef PROBE_SYNC2
#define GSYNC() do { xcd_barrier(xbar); xcd_barrier(xbar); } while (0)
#else
#define GSYNC() xcd_barrier(xbar)
#endif
#ifdef PROBE_MIX2
#define MIXREP 2
#else
#define MIXREP 1
#endif
#define PHASE_PTRS() unsigned z_, zv_; asm volatile("v_mov_b32 %0, 0" : "=v"(zv_)); z_ = __builtin_amdgcn_readfirstlane(zv_); \
    const int tidp = (int)threadIdx.x + (int)zv_, lanep = tidp & 63, wavep = __builtin_amdgcn_readfirstlane(tidp >> 6), gwp = bx * NWAVES + wavep; (void)lanep; (void)gwp; \
    const __attribute__((address_space(4))) Args* ap = (const __attribute__((address_space(4))) Args*)((const __attribute__((address_space(4))) char*)__builtin_amdgcn_kernarg_segment_ptr() + z_); \
    unsigned char* ws = ap->ws; const unsigned char* wl = ws + WS_W + (size_t)l * WL_STRIDE; (void)wl; const int Gp = G + (int)z_, bxp = bx + (int)z_; (void)Gp; (void)bxp
__global__ void __launch_bounds__(NTHREADS, 2) fwd_megakernel(Args a) {
    extern __shared__ __attribute__((aligned(16))) unsigned char lds_raw[];
    cg::grid_group grid = cg::this_grid();
    LAS unsigned char* lds = (LAS unsigned char*)lds_raw;
    const int tid = threadIdx.x, lane = tid & 63, wave = __builtin_amdgcn_readfirstlane(tid >> 6);
    const int G = gridDim.x, bx = blockIdx.x, gw = bx * NWAVES + wave, ngw = G * NWAVES;
    (void)gw; (void)lane;
    volatile LAS unsigned* xst = (volatile LAS unsigned*)(lds + LDS_BYTES - 64);
    if (tid < 16) xst[tid] = 0u;
    __syncthreads();
    const XcdBarrier xbar = xcd_barrier_post((unsigned*)(a.ws + WS_CTL), xst);

    { const int l = 0; PHASE_PTRS(); LAS float* scr = (LAS float*)(lds + wavep * 16640);
#ifndef SKIP_CVT
        for (int it = gwp; it < DEPTH * IT_LAYER; it += ngw) convert_item(ap, it, scr, lanep);
#ifdef PROBE_CVT2
        for (int it = gwp; it < DEPTH * IT_LAYER; it += ngw) convert_item(ap, it, scr, lanep);
#endif
#endif
        row_init(ap->in[0], ap->out, (bf16*)(ws + WS_U), gwp, ngw, lanep); }
    grid.sync();

#pragma unroll 1
    for (int l = 0; l < DEPTH; ++l) {
        { PHASE_PTRS(); pg8::Gemm g{(const pg8::bf16_t*)(ws + WS_U), (const pg8::bf16_t*)(wl + WL_MAIN), MTOK, 4096, DM}; pg8::StaticOrder S; S.init(MTOK, 4096, Gp, bxp);
            typedef pg8::EpiWs<0, WS_QK, WS_UGLU, WS_RXY> EpiT; EpiT E{ws};
            GEMMCALL pg8::gemm_phase<EpiT, pg8::StaticOrder, true, true>(lds, g, S, E); }
        { PHASE_PTRS(); pg8::Gemm g{(const pg8::bf16_t*)(wl + WL_V), (const pg8::bf16_t*)(ws + WS_U), 1024, MTOK, DM}; pg8::StaticOrder S; S.init(1024, MTOK, Gp, bxp);
            typedef pg8::EpiWs<1, WS_VT, 0, 0> EpiT; EpiT E{ws};
            GEMMCALL pg8::gemm_phase<EpiT, pg8::StaticOrder, true, true>(lds, g, S, E); }
        GSYNC();
#pragma unroll 1
        for (int rep = 0; rep < MIXREP; ++rep)
#pragma unroll 1
        for (int unit = bx; unit < 256; unit += G) {
#ifndef SKIP_ATTN
            { PHASE_PTRS(); attn_unit((const bf16*)(ws + WS_QK), (const bf16*)(ws + WS_VT), (bf16*)(ws + WS_MIXED), unit >> 6, unit & 63, (LAS float*)lds, wavep, lanep); }
#endif
#ifndef SKIP_CONV
            { PHASE_PTRS(); conv_unit((const bf16*)(ws + WS_UGLU), ap->in[10] + (size_t)l * 31 * 512, ap->in[11] + l * 512, ap->in[12] + l * 512, ap->in[13] + l * 512, (bf16*)(ws + WS_MIXED), unit * 32, lds, tidp, wavep, lanep); }
#endif
#ifndef SKIP_LRU1
            { PHASE_PTRS(); float* SUMA = (float*)(ws + WS_SUM);
              lru1_unit((const bf16*)(ws + WS_RXY), ap->in[14] + (size_t)l * 4 * 512, ap->in[15] + l * 512, (const bf16*)(wl + WL_LRU), ap->in[17] + l * 512, ap->in[19] + l * 512, ap->in[20] + l * 512,
                      (float*)(ws + WS_HLOC), (float*)(ws + WS_ACUM), SUMA, SUMA + 256 * 512, unit * 32, lds, tidp, wavep, lanep); }
#endif
        }
        GSYNC();
#pragma unroll 1
        for (int unit = bx; unit < 256; unit += G) { PHASE_PTRS(); float* SUMA = (float*)(ws + WS_SUM);
            lru2_unit((const bf16*)(ws + WS_RXY), (const float*)(ws + WS_HLOC), (const float*)(ws + WS_ACUM), SUMA, SUMA + 256 * 512, (bf16*)(ws + WS_MIXED), unit * 32, lds, tidp, wavep, lanep); }
        GSYNC();
        { PHASE_PTRS(); pg8::Gemm g{(const pg8::bf16_t*)(ws + WS_MIXED), (const pg8::bf16_t*)(wl + WL_OUT), MTOK, DM, DM}; pg8::StaticOrder S; S.init(MTOK, DM, Gp, bxp);
            typedef pg8::EpiWs<3, WS_O, 0, 0> EpiT; EpiT E{ws};
            GEMMCALL pg8::gemm_phase<EpiT, pg8::StaticOrder, true, true>(lds, g, S, E); }
        GSYNC();
        { PHASE_PTRS(); row_res((const float*)(ws + WS_O), ap->in[4] + l * DM, ap->out, (bf16*)(ws + WS_U), true, gwp, ngw, lanep); }
        GSYNC();
        { PHASE_PTRS(); pg8::Gemm g{(const pg8::bf16_t*)(ws + WS_U), (const pg8::bf16_t*)(wl + WL_GU), MTOK, NGU, DM}; pg8::StaticOrder S; S.init(MTOK, NGU, Gp, bxp);
            typedef pg8::EpiWs<2, 0, WS_F, 0> EpiT; EpiT E{ws};
            GEMMCALL pg8::gemm_phase<EpiT, pg8::StaticOrder, true, true>(lds, g, S, E); }
        GSYNC();
        { PHASE_PTRS(); pg8::Gemm g{(const pg8::bf16_t*)(ws + WS_F), (const pg8::bf16_t*)(wl + WL_DOWN), MTOK, DM, DFF}; pg8::StaticOrder S; S.init(MTOK, DM, Gp, bxp);
            typedef pg8::EpiWs<3, WS_O, 0, 0> EpiT; EpiT E{ws};
            GEMMCALL pg8::gemm_phase<EpiT, pg8::StaticOrder, true, true>(lds, g, S, E); }
        GSYNC();
        { PHASE_PTRS(); row_res((const float*)(ws + WS_O), ap->in[6] + l * DM, ap->out, (bf16*)(ws + WS_U), l + 1 < DEPTH, gwp, ngw, lanep); }
        if (l + 1 < DEPTH) GSYNC();
    }
}

extern "C" void kernel_launch(void* const* d_in, const int* in_sizes, int n_in, void* d_out, int out_size, void* d_ws, size_t ws_size, hipStream_t stream) {
    static int grid = 0;
    if (grid == 0) {
        if (n_in != 24 || out_size != MTOK * DM || ws_size < WS_END) { fprintf(stderr, "kernel_launch: unexpected shapes (n_in %d out %d ws %zu)\n", n_in, out_size, ws_size); grid = -1; return; }
        int dev = 0, cus = 0, per_cu = 0;
        (void)hipGetDevice(&dev); (void)hipDeviceGetAttribute(&cus, hipDeviceAttributeMultiprocessorCount, dev);
        (void)hipFuncSetAttribute((const void*)fwd_megakernel, hipFuncAttributeMaxDynamicSharedMemorySize, LDS_BYTES);
        if (hipOccupancyMaxActiveBlocksPerMultiprocessor(&per_cu, (const void*)fwd_megakernel, NTHREADS, LDS_BYTES) != hipSuccess || per_cu < 1) per_cu = 1;
        (void)hipGetLastError();
        grid = cus * per_cu; if (grid > 256) grid = 256; if (grid < 1) grid = 256;
    }
    if (grid < 0) return;
    Args a{};
    for (int i = 0; i < 24; ++i) a.in[i] = (const float*)d_in[i];
    a.out = (float*)d_out; a.ws = (unsigned char*)d_ws;
    if (hipMemsetAsync((char*)d_ws + WS_CTL, 0, CTL_BYTES, stream) != hipSuccess) { fprintf(stderr, "kernel_launch: memset failed\n"); return; }
    void* args[] = {&a};
    hipError_t e = hipLaunchCooperativeKernel((const void*)fwd_megakernel, dim3(grid), dim3(NTHREADS), args, LDS_BYTES, stream);
    if (e != hipSuccess) fprintf(stderr, "kernel_launch: cooperative launch failed: %s (grid %d)\n", hipGetErrorString(e), grid);
}
```

```cpp
#include <hip/hip_runtime.h>
#include <hip/hip_cooperative_groups.h>
#include <cstdio>
#include <cstdint>
namespace cg = cooperative_groups;
namespace pg8 {
#define PG8_LAS __attribute__((address_space(3)))
typedef unsigned short bf16_t;
typedef short bf16x8 __attribute__((ext_vector_type(8)));
typedef float f32x4 __attribute__((ext_vector_type(4)));
typedef unsigned u32x4 __attribute__((ext_vector_type(4)));
constexpr int BM = 256, BK = 64, HALF = 128, HTB = HALF * BK * 2  , STAGE_BYTES = 8 * HTB, NXCD = 8, WGM = 8;

__host__ __device__ __forceinline__ int lds_byte(int r, int c) { const int st = (r >> 4) * 2 + (c >> 5), rr = r & 15, cc = c & 31, ob = rr * 64 + cc * 2; return st * 1024 + (ob ^ (((ob >> 9) & 1) << 5)); }
__host__ __device__ __forceinline__ void stage_rc(int b, int& R, int& C) { const int st = b / 1024, sb = b % 1024, swz = sb ^ (((sb >> 9) & 1) << 5); R = (st >> 1) * 16 + swz / 64; C = (st & 1) * 32 + (swz % 64) / 2; }
__host__ __device__ __forceinline__ int perm32(int rho) { const int n = rho >> 4, i = rho & 15; return 8 * (i >> 2) + 4 * n + (i & 3); }

struct Unit { int pm, pn; };
struct Gemm { const bf16_t* A; const bf16_t* Bt; int M, N, K; };

struct StaticOrder {
    int nM, nN, nwg, G, c;
    __host__ __device__ void init(int M, int N, int G_, int c_) { nM = M / BM; nN = N / BM; nwg = nM * nN; G = G_; c = c_; }
    __host__ __device__ bool next(int i, Unit& u) const {
        const long L = (long)i * G + c; if (L >= nwg) return false;
        int wgid = (int)L; { const int q = nwg / NXCD, r = nwg % NXCD, xcd = wgid % NXCD, off = wgid / NXCD; wgid = (xcd < r ? xcd * (q + 1) : r * (q + 1) + (xcd - r) * q) + off; }
        const int nig = WGM * nN, gid = wgid / nig, fm = gid * WGM, gsz = (nM - fm) < WGM ? (nM - fm) : WGM;
        u.pm = fm + ((wgid % nig) % gsz); u.pn = (wgid % nig) / gsz; return true;
    }
    __device__ __forceinline__ void a_ready(const Unit&) const {}
    __device__ __forceinline__ void done(const Unit&) const {}
};


__device__ __forceinline__ float fast_sigmoid(float x) { return __builtin_amdgcn_rcpf(1.0f + __expf(-x)); }
__device__ __forceinline__ unsigned cvt2(float lo, float hi) { typedef float f2_t __attribute__((ext_vector_type(2))); typedef __bf16 b2_t __attribute__((ext_vector_type(2))); f2_t v = {lo, hi}; b2_t b = __builtin_convertvector(v, b2_t); return __builtin_bit_cast(unsigned, b); }

template <int MODE, size_t OFF0, size_t OFF1, size_t OFF2> struct EpiWs {
    static constexpr bool PERM = (MODE != 3), AFTER_DRAIN = false;
    unsigned char* ws;
    __device__ __forceinline__ void operator()(const f32x4 (&acc)[2][2][4][2], const Unit& u, int wr, int wc, int fr, int fq) const {
        const int row0 = u.pm * BM + wr * 64 + fr;
        if constexpr (MODE == 3) {
            float* C = (float*)(ws + OFF0); constexpr int ldc = 2048; const int col0 = u.pn * BM + wc * 32 + 4 * fq;
#pragma unroll
            for (int ai = 0; ai < 2; ++ai)
#pragma unroll
                for (int m = 0; m < 4; ++m) { float* rowp = C + (size_t)(row0 + ai * HALF + m * 16) * ldc + col0;
#pragma unroll
                    for (int bj = 0; bj < 2; ++bj)
#pragma unroll
                        for (int n = 0; n < 2; ++n) *(f32x4*)(rowp + bj * HALF + n * 16) = acc[ai][bj][m][n]; }
        } else {
            const bool pair = (MODE == 2) || (MODE == 0 && u.pn >= 8 && u.pn < 12);
            if (pair) {
                constexpr int ld1 = (MODE == 2) ? 5632 : 512; constexpr int t1 = (MODE == 2) ? 0 : 8; constexpr bool swiglu = (MODE == 2);
                bf16_t* base = (bf16_t*)(ws + OFF1) + (size_t)row0 * ld1 + (u.pn - t1) * 128 + wc * 32 + 8 * fq;
#pragma unroll
                for (int ai = 0; ai < 2; ++ai)
#pragma unroll
                    for (int m = 0; m < 4; ++m) { bf16_t* rowp = base + (size_t)(ai * HALF + m * 16) * ld1;
                        float r[8];
#pragma unroll
                        for (int n = 0; n < 2; ++n)
#pragma unroll
                            for (int j = 0; j < 4; ++j) { const float x0 = acc[ai][0][m][n][j], x1 = acc[ai][1][m][n][j]; const float s = fast_sigmoid(x1); r[4 * n + j] = swiglu ? x0 * x1 * s : x0 * s; }
                        u32x4 w; w.x = cvt2(r[0], r[1]); w.y = cvt2(r[2], r[3]); w.z = cvt2(r[4], r[5]); w.w = cvt2(r[6], r[7]);
                        *(u32x4*)rowp = w; }
            } else {
                bf16_t* base; int ld, colt;
                if (MODE == 1) { base = (bf16_t*)(ws + OFF0); ld = 8192; colt = u.pn * BM; }
                else if (u.pn < 8) { base = (bf16_t*)(ws + OFF0); ld = 2048; colt = u.pn * BM; } else { base = (bf16_t*)(ws + OFF2); ld = 1024; colt = (u.pn - 12) * BM; }
                base += (size_t)row0 * ld + colt + wc * 32 + 8 * fq;
#pragma unroll
                for (int ai = 0; ai < 2; ++ai)
#pragma unroll
                    for (int m = 0; m < 4; ++m) { bf16_t* rowp = base + (size_t)(ai * HALF + m * 16) * ld;
#pragma unroll
                        for (int bj = 0; bj < 2; ++bj) { const f32x4 v0 = acc[ai][bj][m][0], v1 = acc[ai][bj][m][1];
                            u32x4 w; w.x = cvt2(v0[0], v0[1]); w.y = cvt2(v0[2], v0[3]); w.z = cvt2(v1[0], v1[1]); w.w = cvt2(v1[2], v1[3]);
                            *(u32x4*)(rowp + bj * HALF) = w; } }
            }
        }
    }
};
template <class Epi, class Sched, bool ALIGN_EPI = false, bool SP2 = false>
__device__ __forceinline__ void gemm_phase(PG8_LAS unsigned char* lds, const Gemm g, const Sched& S, const Epi& E) {
    const int tid = threadIdx.x, wid = __builtin_amdgcn_readfirstlane(tid >> 6), lane = tid & 63, wr = wid >> 2, wc = wid & 3, fr = lane & 15, fq = lane >> 4;
    const int K = g.K, nt = K / BK;
    unsigned voffA[2], voffB[2];
#pragma unroll
    for (int i = 0; i < 2; ++i) { int R, C; stage_rc(tid * 16 + i * 8192, R, C); const int Rb = Epi::PERM ? ((R & ~31) + perm32(R & 31)) : R;
        voffA[i] = (unsigned)(R * K + C) * 2u; voffB[i] = (unsigned)(Rb * K + C) * 2u; }
    const size_t kstep = (size_t)(BK * 2);
    const size_t hstep = (size_t)HALF * K * 2;
    const size_t tstep = 2 * hstep;
    const unsigned ldsw = (unsigned)wid * 1024u;
    const int aoff = lds_byte(wr * 64 + fr, fq * 8), boff = lds_byte(wc * 32 + fr, fq * 8);
#define PG8_SA(b, h) (((b) * 2 + (h)) * HTB)
#define PG8_SB(b, h) ((4 + (b) * 2 + (h)) * HTB)
#define PG8_STAGE(bufoff, gbase, voff) do { _Pragma("unroll") for (int _i = 0; _i < 2; ++_i) \
        __builtin_amdgcn_global_load_lds((const unsigned*)((const char*)(gbase) + (voff)[_i]), (PG8_LAS unsigned*)(lds + (bufoff) + ldsw + _i * 8192), 16, 0, 0); } while (0)
#define PG8_LDA(dst, b, h) do { _Pragma("unroll") for (int m = 0; m < 4; ++m) _Pragma("unroll") for (int k = 0; k < 2; ++k) dst[m][k] = *(const PG8_LAS bf16x8*)(lds + PG8_SA(b, h) + aoff + m * 2048 + k * 1024); } while (0)
#define PG8_LDB(dst, b, h) do { _Pragma("unroll") for (int n = 0; n < 2; ++n) _Pragma("unroll") for (int k = 0; k < 2; ++k) dst[n][k] = *(const PG8_LAS bf16x8*)(lds + PG8_SB(b, h) + boff + n * 2048 + k * 1024); } while (0)
#define PG8_MMA(ai, bj, At, Bt) do { __builtin_amdgcn_s_setprio(1); _Pragma("unroll") for (int m = 0; m < 4; ++m) _Pragma("unroll") for (int n = 0; n < 2; ++n) _Pragma("unroll") for (int k = 0; k < 2; ++k) \
        acc[ai][bj][m][n] = __builtin_amdgcn_mfma_f32_16x16x32_bf16(Bt[n][k], At[m][k], acc[ai][bj][m][n], 0, 0, 0); __builtin_amdgcn_s_setprio(0); } while (0)
#define PG8_WAIT_V(n) asm volatile("s_waitcnt vmcnt(" #n ")" ::: "memory")
#define PG8_WAIT_L(n) asm volatile("s_waitcnt lgkmcnt(" #n ")" ::: "memory")
#define PG8_BAR __builtin_amdgcn_s_barrier()
#define PG8_SCHED __builtin_amdgcn_sched_barrier(0)
    Unit cur, nxt; int ui = 0;
    if (!S.next(0, cur)) return;
    f32x4 acc[2][2][4][2];
#pragma unroll
    for (int a = 0; a < 2; ++a)
#pragma unroll
        for (int b = 0; b < 2; ++b)
#pragma unroll
            for (int m = 0; m < 4; ++m)
#pragma unroll
                for (int n = 0; n < 2; ++n) acc[a][b][m][n] = (f32x4){0.f, 0.f, 0.f, 0.f};
    bf16x8 At[4][2], B0[2][2], B1[2][2];
    const char* cA = (const char*)g.A + (size_t)cur.pm * tstep; const char* cB = (const char*)g.Bt + (size_t)cur.pn * tstep;
    S.a_ready(cur);
    if constexpr (SP2) {
        PG8_STAGE(PG8_SB(0, 0), cB, voffB); PG8_STAGE(PG8_SB(0, 1), cB + hstep, voffB); PG8_STAGE(PG8_SA(0, 0), cA, voffA); PG8_STAGE(PG8_SA(0, 1), cA + hstep, voffA);
        if (wr == 1) PG8_BAR;
        PG8_WAIT_V(2); PG8_BAR;
        PG8_STAGE(PG8_SB(1, 0), cB + kstep, voffB); PG8_STAGE(PG8_SA(1, 0), cA + kstep, voffA); PG8_STAGE(PG8_SB(1, 1), cB + hstep + kstep, voffB);
        PG8_WAIT_V(6); PG8_BAR;
    } else {
        PG8_STAGE(PG8_SB(0, 0), cB, voffB); PG8_STAGE(PG8_SA(0, 0), cA, voffA); PG8_STAGE(PG8_SB(0, 1), cB + hstep, voffB); PG8_STAGE(PG8_SA(0, 1), cA + hstep, voffA);
        if (wr == 1) PG8_BAR;
        PG8_WAIT_V(4); PG8_BAR;
        PG8_STAGE(PG8_SB(1, 0), cB + kstep, voffB); PG8_STAGE(PG8_SA(1, 0), cA + kstep, voffA); PG8_STAGE(PG8_SB(1, 1), cB + hstep + kstep, voffB);
        PG8_WAIT_V(6); PG8_BAR;
    }
    for (;;) {
        const bool has_next = S.next(ui + 1, nxt);
        const char* nA = has_next ? (const char*)g.A + (size_t)nxt.pm * tstep : cA; const char* nB = has_next ? (const char*)g.Bt + (size_t)nxt.pn * tstep : cB;
        for (int t = 0; t < nt; t += 2) {
            const bool last = (t == nt - 2);
            const char* a1 = cA + (size_t)(t + 1) * kstep;
            const char* a2 = last ? nA : cA + (size_t)(t + 2) * kstep; const char* b2 = last ? nB : cB + (size_t)(t + 2) * kstep;
            const char* a3 = a2 + kstep; const char* b3 = b2 + kstep;
            if (last && has_next) S.a_ready(nxt);
            if constexpr (SP2) {
            PG8_LDB(B0, 0, 0); PG8_LDB(B1, 0, 1); PG8_SCHED; PG8_LDA(At, 0, 0); PG8_STAGE(PG8_SA(1, 1), a1 + hstep, voffA);
            PG8_WAIT_V(8); PG8_WAIT_L(0); PG8_BAR; PG8_MMA(0, 0, At, B0); PG8_MMA(0, 1, At, B1); PG8_BAR; PG8_SCHED;
            PG8_LDA(At, 0, 1); PG8_STAGE(PG8_SB(0, 0), b2, voffB); PG8_STAGE(PG8_SB(0, 1), b2 + hstep, voffB); PG8_STAGE(PG8_SA(0, 0), a2, voffA);
            PG8_WAIT_V(8); PG8_WAIT_L(0); PG8_BAR; PG8_MMA(1, 0, At, B0); PG8_MMA(1, 1, At, B1); PG8_BAR; PG8_SCHED;
            PG8_LDB(B0, 1, 0); PG8_LDB(B1, 1, 1); PG8_SCHED; PG8_LDA(At, 1, 0); PG8_STAGE(PG8_SA(0, 1), a2 + hstep, voffA);
            PG8_WAIT_V(8); PG8_WAIT_L(0); PG8_BAR; PG8_MMA(0, 0, At, B0); PG8_MMA(0, 1, At, B1); PG8_BAR; PG8_SCHED;
            PG8_LDA(At, 1, 1); PG8_STAGE(PG8_SB(1, 0), b3, voffB); PG8_STAGE(PG8_SB(1, 1), b3 + hstep, voffB); PG8_STAGE(PG8_SA(1, 0), a3, voffA);
            PG8_WAIT_V(8); PG8_WAIT_L(0); PG8_BAR; PG8_MMA(1, 0, At, B0); PG8_MMA(1, 1, At, B1); PG8_BAR; PG8_SCHED;
            } else {
            PG8_LDB(B0, 0, 0); PG8_SCHED; PG8_LDA(At, 0, 0); PG8_STAGE(PG8_SA(1, 1), a1 + hstep, voffA);
            PG8_WAIT_L(8); PG8_BAR; PG8_WAIT_L(0); PG8_MMA(0, 0, At, B0); PG8_BAR; PG8_SCHED;
            PG8_LDB(B1, 0, 1); PG8_STAGE(PG8_SB(0, 0), b2, voffB);
            PG8_BAR; PG8_WAIT_L(0); PG8_MMA(0, 1, At, B1); PG8_BAR;
            PG8_LDA(At, 0, 1); PG8_STAGE(PG8_SA(0, 0), a2, voffA);
            PG8_BAR; PG8_WAIT_L(0); PG8_MMA(1, 0, At, B0); PG8_BAR; PG8_SCHED;
            PG8_STAGE(PG8_SB(0, 1), b2 + hstep, voffB);
            PG8_WAIT_V(6); PG8_BAR; PG8_MMA(1, 1, At, B1); PG8_BAR;
            PG8_LDB(B0, 1, 0); PG8_SCHED; PG8_LDA(At, 1, 0); PG8_STAGE(PG8_SA(0, 1), a2 + hstep, voffA);
            PG8_WAIT_L(8); PG8_BAR; PG8_WAIT_L(0); PG8_MMA(0, 0, At, B0); PG8_BAR; PG8_SCHED;
            PG8_LDB(B1, 1, 1); PG8_STAGE(PG8_SB(1, 0), b3, voffB);
            PG8_BAR; PG8_WAIT_L(0); PG8_MMA(0, 1, At, B1); PG8_BAR;
            PG8_LDA(At, 1, 1); PG8_STAGE(PG8_SA(1, 0), a3, voffA);
            PG8_BAR; PG8_WAIT_L(0); PG8_MMA(1, 0, At, B0); PG8_BAR; PG8_SCHED;
            PG8_STAGE(PG8_SB(1, 1), b3 + hstep, voffB);
            PG8_WAIT_V(6); PG8_BAR; PG8_MMA(1, 1, At, B1); PG8_BAR;
            }
        }
        if constexpr (ALIGN_EPI) { if (wr == 0) PG8_BAR; }
        if constexpr (!Epi::AFTER_DRAIN) { E(acc, cur, wr, wc, fr, fq); S.done(cur); }
        if (!has_next) break;
#pragma unroll
        for (int a = 0; a < 2; ++a)
#pragma unroll
            for (int b = 0; b < 2; ++b)
#pragma unroll
                for (int m = 0; m < 4; ++m)
#pragma unroll
                    for (int n = 0; n < 2; ++n) acc[a][b][m][n] = (f32x4){0.f, 0.f, 0.f, 0.f};
        cur = nxt; cA = nA; cB = nB; ++ui;
        if constexpr (ALIGN_EPI) { if (wr == 1) PG8_BAR; }
    }
    PG8_WAIT_V(0);
    if constexpr (!ALIGN_EPI) { if (wr == 0) PG8_BAR; }
    PG8_BAR;
    if constexpr (Epi::AFTER_DRAIN) { E.fused(acc, cur, wr, wc, fr, fq, lds, wid, lane); S.done(cur); }
#undef PG8_SA
#undef PG8_SB
#undef PG8_STAGE
#undef PG8_LDA
#undef PG8_LDB
#undef PG8_MMA
#undef PG8_WAIT_V
#undef PG8_WAIT_L
#undef PG8_BAR
#undef PG8_SCHED
}
}

constexpr int DM = 2048, NB = 4, SEQ = 2048, DEPTH = 4, MTOK = NB * SEQ;
constexpr int INCOLS = 5120, DFF = 5632, NGU = 2 * DFF;
constexpr float EPS = 1e-6f;
constexpr int NWAVES = 8, NTHREADS = 512;
constexpr int LDS_BYTES = 147456;

constexpr size_t MiB = 1u << 20;
constexpr size_t WS_CTL = 0, CTL_BYTES = 16384;
constexpr size_t WS_U = 1 * MiB, WS_QK = 33 * MiB, WS_VT = 65 * MiB, WS_UGLU = 81 * MiB, WS_RXY = 89 * MiB, WS_MIXED = 105 * MiB;
constexpr size_t WS_HLOC = 137 * MiB, WS_ACUM = 153 * MiB, WS_SUM = 169 * MiB, WS_O = 170 * MiB, WS_F = 234 * MiB, WS_W = 322 * MiB;
constexpr size_t WL_MAIN = 0, WL_V = 16 * MiB, WL_OUT = 20 * MiB, WL_GU = 28 * MiB, WL_DOWN = 72 * MiB, WL_LRU = 94 * MiB, WL_STRIDE = 95 * MiB;
constexpr size_t WS_END = WS_W + 4 * WL_STRIDE;

#define LAS __attribute__((address_space(3)))
#define DI __device__ __forceinline__
typedef unsigned short bf16;
typedef short bf16x8 __attribute__((ext_vector_type(8)));
typedef float f32x4 __attribute__((ext_vector_type(4)));
typedef float f32x16 __attribute__((ext_vector_type(16)));
typedef unsigned u32x2 __attribute__((ext_vector_type(2)));
typedef unsigned u32x4 __attribute__((ext_vector_type(4)));
#define MFMA32(a, b, c) __builtin_amdgcn_mfma_f32_32x32x16_bf16((a), (b), (c), 0, 0, 0)

DI unsigned pk2(float lo, float hi) { return pg8::cvt2(lo, hi); }
DI float bf2f(unsigned short b) { return __uint_as_float(((unsigned)b) << 16); }
DI float bflo(unsigned w) { return __uint_as_float(w << 16); }
DI float bfhi(unsigned w) { return __uint_as_float(w & 0xffff0000u); }
DI float sigm(float x) { return __builtin_amdgcn_rcpf(1.0f + __expf(-x)); }
template <int CTRL, int ROWMASK> DI float dppf(float old, float src) { return __builtin_bit_cast(float, __builtin_amdgcn_update_dpp(__builtin_bit_cast(int, old), __builtin_bit_cast(int, src), CTRL, ROWMASK, 0xf, false)); }
DI float wave_sum(float v) {
    v += dppf<0x111, 0xf>(0.f, v); v += dppf<0x112, 0xf>(0.f, v); v += dppf<0x114, 0xf>(0.f, v); v += dppf<0x118, 0xf>(0.f, v);
    v += dppf<0x142, 0xa>(0.f, v); v += dppf<0x143, 0xc>(0.f, v);
    return __builtin_bit_cast(float, __builtin_amdgcn_readlane(__builtin_bit_cast(int, v), 63));
}
#define LDS_WAIT() asm volatile("s_waitcnt lgkmcnt(0)" ::: "memory")

struct Args { const float* in[24]; float* out; unsigned char* ws; };

DI void tr_item(const float* __restrict__ src, int pitch, int col0, int k0, const float* __restrict__ gain, bf16* __restrict__ dst, int dpitch, int drow0, LAS float* scr, int lane) {
#pragma unroll 8
    for (int kk = 0; kk < 64; ++kk) scr[kk * 65 + lane] = src[(size_t)(k0 + kk) * pitch + col0 + lane];
    LDS_WAIT();
    const int c = lane & 7;
    float g[8];
#pragma unroll
    for (int j = 0; j < 8; ++j) g[j] = gain ? gain[k0 + 8 * c + j] : 1.0f;
#pragma unroll
    for (int jj = 0; jj < 8; ++jj) { const int n = (lane >> 3) + 8 * jj; const LAS float* s = scr + (8 * c) * 65 + n;
        u32x4 o; o.x = pk2(s[0] * g[0], s[65] * g[1]); o.y = pk2(s[2 * 65] * g[2], s[3 * 65] * g[3]); o.z = pk2(s[4 * 65] * g[4], s[5 * 65] * g[5]); o.w = pk2(s[6 * 65] * g[6], s[7 * 65] * g[7]);
        *(u32x4*)(dst + (size_t)(drow0 + n) * dpitch + k0 + 8 * c) = o; }
    LDS_WAIT();
}
constexpr int IT_MAIN = 32 * 64, IT_V = 32 * 16, IT_OUT = 32 * 32, IT_GU = 32 * 176, IT_DOWN = 88 * 32, IT_LRU = 32;
constexpr int IT_LAYER = IT_MAIN + IT_V + IT_OUT + IT_GU + IT_DOWN + IT_LRU;
DI void convert_item(const __attribute__((address_space(4))) Args* ap, int it, LAS float* scr, int lane) {
    const int l = it / IT_LAYER; int idx = it % IT_LAYER;
    unsigned char* wl = ap->ws + WS_W + (size_t)l * WL_STRIDE;
    if (idx < IT_MAIN) { const int kb = idx / 64, nb = idx % 64, drow0 = nb * 64, pn = drow0 / 256, w = drow0 % 256;
        const int col0 = pn < 8 ? drow0 : (pn < 12 ? (w < 128 ? 3072 + 128 * (pn - 8) + w : 3584 + 128 * (pn - 8) + (w - 128)) : drow0 + 1024);
        tr_item(ap->in[1] + (size_t)l * DM * INCOLS, INCOLS, col0, kb * 64, ap->in[3] + l * DM, (bf16*)(wl + WL_MAIN), DM, drow0, scr, lane); return; }
    idx -= IT_MAIN;
    if (idx < IT_V) { const int kb = idx / 16, nb = idx % 16;
        tr_item(ap->in[1] + (size_t)l * DM * INCOLS, INCOLS, 2048 + nb * 64, kb * 64, ap->in[3] + l * DM, (bf16*)(wl + WL_V), DM, nb * 64, scr, lane); return; }
    idx -= IT_V;
    if (idx < IT_OUT) { const int kb = idx / 32, nb = idx % 32, k0 = kb * 64;
        const float* g = k0 < 1024 ? ap->in[7] + l * 1024 : (k0 < 1536 ? ap->in[8] + l * 512 - 1024 : ap->in[9] + l * 512 - 1536);
        tr_item(ap->in[2] + (size_t)l * DM * DM, DM, nb * 64, k0, g, (bf16*)(wl + WL_OUT), DM, nb * 64, scr, lane); return; }
    idx -= IT_OUT;
    if (idx < IT_GU) { const int kb = idx / 176, nb = idx % 176, drow0 = nb * 64, pn = drow0 / 256, w = drow0 % 256;
        const float* src = (w < 128 ? ap->in[22] : ap->in[21]) + (size_t)l * DM * DFF; const int col0 = 128 * pn + (w & 127);
        tr_item(src, DFF, col0, kb * 64, ap->in[5] + l * DM, (bf16*)(wl + WL_GU), DM, drow0, scr, lane); return; }
    idx -= IT_GU;
    if (idx < IT_DOWN) { const int kb = idx / 32, nb = idx % 32;
        tr_item(ap->in[23] + (size_t)l * DFF * DM, DM, nb * 64, kb * 64, nullptr, (bf16*)(wl + WL_DOWN), DFF, nb * 64, scr, lane); return; }
    idx -= IT_DOWN;
    { const int gate = idx >> 4, n = (idx >> 2) & 3, kb = (idx >> 1) & 1, nb = idx & 1;
        const float* src = (gate ? ap->in[18] : ap->in[16]) + (size_t)l * 4 * 128 * 128 + (size_t)n * 128 * 128;
        tr_item(src, 128, nb * 64, kb * 64, nullptr, (bf16*)(wl + WL_LRU) + (size_t)(gate * 4 + n) * 128 * 128, 128, nb * 64, scr, lane); }
}

DI void row_init(const float* __restrict__ x, float* __restrict__ h, bf16* __restrict__ u, int gw, int ngw, int lane) {
    for (int m = gw; m < MTOK; m += ngw) {
        const f32x4* xr = (const f32x4*)(x + (size_t)m * DM) + lane; f32x4 v[8]; float ss = 0.f;
#pragma unroll
        for (int j = 0; j < 8; ++j) { v[j] = xr[64 * j]; ss += (v[j].x * v[j].x + v[j].y * v[j].y) + (v[j].z * v[j].z + v[j].w * v[j].w); }
        const float r = rsqrtf(wave_sum(ss) * (1.0f / DM) + EPS);
        f32x4* hr = (f32x4*)(h + (size_t)m * DM) + lane; u32x2* ur = (u32x2*)(u + (size_t)m * DM) + lane;
#pragma unroll
        for (int j = 0; j < 8; ++j) { hr[64 * j] = v[j]; u32x2 w; w.x = pk2(v[j].x * r, v[j].y * r); w.y = pk2(v[j].z * r, v[j].w * r); ur[64 * j] = w; }
    }
}
DI void row_res(const float* __restrict__ o, const float* __restrict__ g, float* __restrict__ h, bf16* __restrict__ u, bool write_u, int gw, int ngw, int lane) {
    for (int m = gw; m < MTOK; m += ngw) {
        const f32x4* orow = (const f32x4*)(o + (size_t)m * DM) + lane; f32x4 v[8]; float ss = 0.f;
#pragma unroll
        for (int j = 0; j < 8; ++j) { v[j] = orow[64 * j]; ss += (v[j].x * v[j].x + v[j].y * v[j].y) + (v[j].z * v[j].z + v[j].w * v[j].w); }
        const float r = rsqrtf(wave_sum(ss) * (1.0f / DM) + EPS);
        f32x4* hr = (f32x4*)(h + (size_t)m * DM) + lane; const f32x4* gr = (const f32x4*)g + lane; float s2 = 0.f;
#pragma unroll
        for (int j = 0; j < 8; ++j) { const f32x4 hv = hr[64 * j], gv = gr[64 * j]; v[j] = hv + v[j] * r * gv; hr[64 * j] = v[j]; s2 += (v[j].x * v[j].x + v[j].y * v[j].y) + (v[j].z * v[j].z + v[j].w * v[j].w); }
        if (write_u) { const float r2 = rsqrtf(wave_sum(s2) * (1.0f / DM) + EPS); u32x2* ur = (u32x2*)(u + (size_t)m * DM) + lane;
#pragma unroll
            for (int j = 0; j < 8; ++j) { u32x2 w; w.x = pk2(v[j].x * r2, v[j].y * r2); w.y = pk2(v[j].z * r2, v[j].w * r2); ur[64 * j] = w; } }
    }
}

DI void attn_unit(const bf16* __restrict__ QK, const bf16* __restrict__ VT, bf16* __restrict__ mixed, int b, int qt, LAS float* red, int wave, int lane) {
    const int n = lane & 31, hh = lane >> 5, h = wave;
    const int qpos = qt * 32 + n; const size_t tokq = (size_t)b * SEQ + qpos;
    const bf16* qp = QK + tokq * 2048 + h * 128 + 8 * hh;
    bf16x8 qf[8];
#pragma unroll
    for (int s = 0; s < 8; ++s) qf[s] = *(const bf16x8*)(qp + 16 * s);
    f32x16 o[4];
#pragma unroll
    for (int d = 0; d < 4; ++d)
#pragma unroll
        for (int i = 0; i < 16; ++i) o[d][i] = 0.f;
    float R = 0.f;
    const float scale = 0.08838834764831845f;
    const bf16* kbase = QK + ((size_t)b * SEQ + n) * 2048 + 1024 + h * 128 + 8 * hh;
    bf16x8 kf[8];
#pragma unroll
    for (int st = 0; st < 8; ++st) kf[st] = *(const bf16x8*)(kbase + (size_t)(qt * 32) * 2048 + 16 * st);
    for (int kt = qt; kt >= 0; --kt) {
        const int key0 = kt * 32;
        f32x16 s;
#pragma unroll
        for (int i = 0; i < 16; ++i) s[i] = 0.f;
#pragma unroll
        for (int st = 0; st < 8; ++st) s = MFMA32(kf[st], qf[st], s);
        { const int ktn = kt > 0 ? kt - 1 : 0;
#pragma unroll
            for (int st = 0; st < 8; ++st) kf[st] = *(const bf16x8*)(kbase + (size_t)(ktn * 32) * 2048 + 16 * st); }
        const bf16* vbase = VT + (size_t)(h * 128 + n) * MTOK + (size_t)b * SEQ + key0 + 4 * hh;
        u32x2 vlo[2][4], vhi[2][4];
#pragma unroll
        for (int ks = 0; ks < 2; ++ks)
#pragma unroll
            for (int dt = 0; dt < 4; ++dt) { const bf16* vp = vbase + (size_t)(32 * dt) * MTOK + 16 * ks; vlo[ks][dt] = *(const u32x2*)vp; vhi[ks][dt] = *(const u32x2*)(vp + 8); }
        float lk[16], lw[16];
#pragma unroll
        for (int i = 0; i < 16; ++i) { const float z = s[i] * scale; const int kpos = key0 + 8 * (i >> 2) + 4 * hh + (i & 3);
            const float sp = fmaxf(z, 0.f) + __logf(1.0f + __expf(-fabsf(z)));
            lk[i] = (kpos < qpos) ? -sp : 0.f; lw[i] = (kpos < qpos) ? (z - sp) : -1.0e30f; }
        float gt[4], og[4];
#pragma unroll
        for (int c = 0; c < 4; ++c) { gt[c] = (lk[4 * c] + lk[4 * c + 1]) + (lk[4 * c + 2] + lk[4 * c + 3]); og[c] = __shfl_xor(gt[c], 32); }
        float run = R; float w[16];
#pragma unroll
        for (int c = 3; c >= 0; --c) {
            const float c3 = run + (hh == 0 ? og[c] : 0.f), c2 = c3 + lk[4 * c + 3], c1 = c2 + lk[4 * c + 2], c0 = c1 + lk[4 * c + 1];
            w[4 * c + 3] = __expf(lw[4 * c + 3] + c3); w[4 * c + 2] = __expf(lw[4 * c + 2] + c2); w[4 * c + 1] = __expf(lw[4 * c + 1] + c1); w[4 * c] = __expf(lw[4 * c] + c0);
            run += gt[c] + og[c];
        }
        R = run;
#pragma unroll
        for (int ks = 0; ks < 2; ++ks) {
            u32x4 pw; pw.x = pk2(w[8 * ks], w[8 * ks + 1]); pw.y = pk2(w[8 * ks + 2], w[8 * ks + 3]); pw.z = pk2(w[8 * ks + 4], w[8 * ks + 5]); pw.w = pk2(w[8 * ks + 6], w[8 * ks + 7]);
            const bf16x8 pf = __builtin_bit_cast(bf16x8, pw);
#pragma unroll
            for (int dt = 0; dt < 4; ++dt) { u32x4 vv; vv.x = vlo[ks][dt].x; vv.y = vlo[ks][dt].y; vv.z = vhi[ks][dt].x; vv.w = vhi[ks][dt].y;
                o[dt] = MFMA32(__builtin_bit_cast(bf16x8, vv), pf, o[dt]); }
        }
        if (__all(R < -110.0f)) break;
    }
    float ss = 0.f;
#pragma unroll
    for (int d = 0; d < 4; ++d)
#pragma unroll
        for (int i = 0; i < 16; ++i) ss += o[d][i] * o[d][i];
    ss += __shfl_xor(ss, 32);
    if (hh == 0) red[wave * 32 + n] = ss;
    __syncthreads();
    float tot = 0.f;
#pragma unroll
    for (int w8 = 0; w8 < 8; ++w8) tot += red[w8 * 32 + n];
    const float r = rsqrtf(tot * (1.0f / 1024.0f) + EPS);
    bf16* op = mixed + tokq * 2048 + h * 128 + 4 * hh;
#pragma unroll
    for (int dt = 0; dt < 4; ++dt)
#pragma unroll
        for (int c = 0; c < 4; ++c) { u32x2 wv; wv.x = pk2(o[dt][4 * c] * r, o[dt][4 * c + 1] * r); wv.y = pk2(o[dt][4 * c + 2] * r, o[dt][4 * c + 3] * r);
            *(u32x2*)(op + 32 * dt + 8 * c) = wv; }
    __syncthreads();
}

DI void conv_unit(const bf16* __restrict__ UGLU, const float* __restrict__ dww, const float* __restrict__ dwb, const float* __restrict__ lng, const float* __restrict__ lnb,
                  bf16* __restrict__ mixed, int t0, LAS unsigned char* lds, int tid, int wave, int lane) {
    LAS bf16* Xin = (LAS bf16*)lds;
    LAS float* Y = (LAS float*)(lds + 63488);
    const int bstart = (t0 / SEQ) * SEQ;
    for (int r = wave; r < 62; r += 8) { const int tok = t0 - 30 + r; u32x4 v = {0u, 0u, 0u, 0u};
        if (tok >= bstart) v = *(const u32x4*)(UGLU + (size_t)tok * 512 + lane * 8);
        *(LAS u32x4*)(Xin + r * 512 + lane * 8) = v; }
    __syncthreads();
    const int c = tid;
    float in[62];
#pragma unroll
    for (int r = 0; r < 62; ++r) in[r] = bf2f(Xin[r * 512 + c]);
    float acc[32]; const float bias = dwb[c];
#pragma unroll
    for (int t = 0; t < 32; ++t) acc[t] = bias;
#pragma unroll
    for (int j = 0; j < 31; ++j) { const float wj = dww[j * 512 + c];
#pragma unroll
        for (int t = 0; t < 32; ++t) acc[t] += wj * in[t + j]; }
#pragma unroll
    for (int t = 0; t < 32; ++t) Y[t * 512 + c] = acc[t];
    __syncthreads();
    const f32x4 g0 = *(const f32x4*)(lng + 4 * lane), g1 = *(const f32x4*)(lng + 256 + 4 * lane), b0 = *(const f32x4*)(lnb + 4 * lane), b1 = *(const f32x4*)(lnb + 256 + 4 * lane);
    for (int t = wave; t < 32; t += 8) {
        f32x4 v0 = *(const LAS f32x4*)(Y + t * 512 + 4 * lane), v1 = *(const LAS f32x4*)(Y + t * 512 + 256 + 4 * lane);
        const float mean = wave_sum((v0.x + v0.y) + (v0.z + v0.w) + (v1.x + v1.y) + (v1.z + v1.w)) * (1.0f / 512.0f);
        v0 = v0 - mean; v1 = v1 - mean;
        const float var = wave_sum((v0.x * v0.x + v0.y * v0.y) + (v0.z * v0.z + v0.w * v0.w) + (v1.x * v1.x + v1.y * v1.y) + (v1.z * v1.z + v1.w * v1.w)) * (1.0f / 512.0f);
        const float rs = rsqrtf(var + EPS);
        v0 = v0 * rs * g0 + b0; v1 = v1 * rs * g1 + b1;
        float ss = 0.f;
#pragma unroll
        for (int e = 0; e < 4; ++e) { v0[e] = v0[e] * sigm(v0[e]); v1[e] = v1[e] * sigm(v1[e]); ss += v0[e] * v0[e] + v1[e] * v1[e]; }
        const float r2 = rsqrtf(wave_sum(ss) * (1.0f / 512.0f) + EPS);
        bf16* op = mixed + (size_t)(t0 + t) * 2048 + 1024 + 4 * lane;
        u32x2 w0, w1; w0.x = pk2(v0.x * r2, v0.y * r2); w0.y = pk2(v0.z * r2, v0.w * r2); w1.x = pk2(v1.x * r2, v1.y * r2); w1.y = pk2(v1.z * r2, v1.w * r2);
        *(u32x2*)op = w0; *(u32x2*)(op + 256) = w1;
    }
    __syncthreads();
}

DI void lru1_unit(const bf16* __restrict__ RXY, const float* __restrict__ cw, const float* __restrict__ cb, const bf16* __restrict__ Wl, const float* __restrict__ ba, const float* __restrict__ bi,
                  const float* __restrict__ lam, float* __restrict__ HLOC, float* __restrict__ ACUM, float* __restrict__ SUMA, float* __restrict__ SUMH, int t0, LAS unsigned char* lds, int tid, int wave, int lane) {
    constexpr int XP = 520;
    LAS bf16* X = (LAS bf16*)lds;
    const int bstart = (t0 / SEQ) * SEQ;
    { const int c = tid; const float w0 = cw[c], w1 = cw[512 + c], w2 = cw[1024 + c], w3 = cw[1536 + c], bb = cb[c];
        float x[35];
#pragma unroll
        for (int r = 0; r < 35; ++r) { const int tok = t0 - 3 + r; x[r] = (tok >= bstart) ? bf2f(RXY[(size_t)tok * 1024 + c]) : 0.f; }
#pragma unroll
        for (int t = 0; t < 32; ++t) { const float xr = bb + (w0 * x[t] + w1 * x[t + 1]) + (w2 * x[t + 2] + w3 * x[t + 3]); X[t * XP + c] = (bf16)(pk2(xr, 0.f) & 0xffffu); } }
    __syncthreads();
    const int n = wave >> 1, half = wave & 1, tl = lane & 31, hh = lane >> 5;
    f32x16 acc[2][2];
#pragma unroll
    for (int g = 0; g < 2; ++g)
#pragma unroll
        for (int mt = 0; mt < 2; ++mt)
#pragma unroll
            for (int i = 0; i < 16; ++i) acc[g][mt][i] = 0.f;
#pragma unroll
    for (int s = 0; s < 8; ++s) { const bf16x8 bfr = *(const LAS bf16x8*)(X + tl * XP + 128 * n + 16 * s + 8 * hh);
#pragma unroll
        for (int g = 0; g < 2; ++g)
#pragma unroll
            for (int mt = 0; mt < 2; ++mt) { const bf16* wp = Wl + ((size_t)(g * 4 + n) * 128 + 64 * half + 32 * mt + tl) * 128 + 16 * s + 8 * hh;
                acc[g][mt] = MFMA32(*(const bf16x8*)wp, bfr, acc[g][mt]); } }
    const int chunk = t0 / 32;
    const int chb = 128 * n + 64 * half + 4 * hh;
    f32x4 ba4[8], bi4[8], sp4[8];
#pragma unroll
    for (int q = 0; q < 8; ++q) { const int ch0 = chb + 8 * q;
        ba4[q] = *(const f32x4*)(ba + ch0); bi4[q] = *(const f32x4*)(bi + ch0); sp4[q] = *(const f32x4*)(lam + ch0); }
#pragma unroll
    for (int q = 0; q < 8; ++q)
#pragma unroll
        for (int e = 0; e < 4; ++e) { const float x = __expf(-sp4[q][e]);
            sp4[q][e] = x * (1.0f + x * (-0.5f + x * (0.33333334f + x * (-0.25f + x * (0.2f + x * (-0.16666667f + x * 0.14285715f)))))); }
#pragma unroll
    for (int mt = 0; mt < 2; ++mt)
#pragma unroll
        for (int cg4 = 0; cg4 < 4; ++cg4) {
            const int q = 4 * mt + cg4, ch0 = chb + 8 * q;
            const u32x2 xw = *(const LAS u32x2*)(X + tl * XP + ch0);
            const float xr[4] = {bflo(xw.x), bfhi(xw.x), bflo(xw.y), bfhi(xw.y)};
            float av[4], bv[4];
#pragma unroll
            for (int e = 0; e < 4; ++e) { const int i = 4 * cg4 + e;
                const float r = sigm(acc[0][mt][i] + ba4[q][e]), ig = sigm(acc[1][mt][i] + bi4[q][e]);
                const float la = -8.0f * r * sp4[q][e];
                const float x2 = 2.0f * la;
                const float om = -x2 * (1.0f + x2 * (0.5f + x2 * (0.16666667f + x2 * (0.041666668f + x2 * (0.0083333338f + x2 * 0.0013888889f)))));
                av[e] = __expf(la); bv[e] = __builtin_amdgcn_sqrtf(fmaxf(om, 0.f)) * (ig * xr[e]); }
#define LRU_SCAN_STEP(CTRL, RM) { _Pragma("unroll") for (int e = 0; e < 4; ++e) { const float ap_ = dppf<CTRL, RM>(1.0f, av[e]), bp_ = dppf<CTRL, RM>(0.0f, bv[e]); bv[e] = av[e] * bp_ + bv[e]; av[e] = av[e] * ap_; } }
            LRU_SCAN_STEP(0x111, 0xf) LRU_SCAN_STEP(0x112, 0xf) LRU_SCAN_STEP(0x114, 0xf) LRU_SCAN_STEP(0x118, 0xf) LRU_SCAN_STEP(0x142, 0xa)
#undef LRU_SCAN_STEP
            const size_t off = (size_t)(t0 + tl) * 512 + ch0;
            *(f32x4*)(HLOC + off) = (f32x4){bv[0], bv[1], bv[2], bv[3]};
            *(f32x4*)(ACUM + off) = (f32x4){av[0], av[1], av[2], av[3]};
            if (tl == 31) { *(f32x4*)(SUMA + (size_t)chunk * 512 + ch0) = (f32x4){av[0], av[1], av[2], av[3]}; *(f32x4*)(SUMH + (size_t)chunk * 512 + ch0) = (f32x4){bv[0], bv[1], bv[2], bv[3]}; }
        }
    __syncthreads();
}

DI void lru2_unit(const bf16* __restrict__ RXY, const float* __restrict__ HLOC, const float* __restrict__ ACUM, const float* __restrict__ SUMA, const float* __restrict__ SUMH,
                  bf16* __restrict__ mixed, int t0, LAS unsigned char* lds, int tid, int wave, int lane) {
    LAS float* carry = (LAS float*)lds;
    const int b = t0 / SEQ, cidx = (t0 % SEQ) / 32;
    { const float* sa = SUMA + (size_t)(b * 64) * 512 + tid; const float* sh = SUMH + (size_t)(b * 64) * 512 + tid; float cr = 0.f;
        for (int k0 = 0; k0 < cidx; k0 += 16) { float A[16], Hh[16];
#pragma unroll
            for (int j = 0; j < 16; ++j) { const bool ok = (k0 + j) < cidx; A[j] = ok ? sa[(size_t)(k0 + j) * 512] : 1.0f; Hh[j] = ok ? sh[(size_t)(k0 + j) * 512] : 0.0f; }
#pragma unroll
            for (int j = 0; j < 16; ++j) cr = A[j] * cr + Hh[j]; }
        carry[tid] = cr; }
    __syncthreads();
    for (int t = wave; t < 32; t += 8) { const size_t tok = (size_t)t0 + t; float y[8]; float ss = 0.f;
#pragma unroll
        for (int jj = 0; jj < 2; ++jj) { const int ch = 4 * lane + 256 * jj;
            const f32x4 hl = *(const f32x4*)(HLOC + tok * 512 + ch), ac = *(const f32x4*)(ACUM + tok * 512 + ch), cr = *(const LAS f32x4*)(carry + ch);
            const u32x2 rw = *(const u32x2*)(RXY + tok * 1024 + 512 + ch); const float ry[4] = {bflo(rw.x), bfhi(rw.x), bflo(rw.y), bfhi(rw.y)};
#pragma unroll
            for (int e = 0; e < 4; ++e) { const float hv = hl[e] + ac[e] * cr[e]; const float x = ry[e];
                const float u2 = 1.5957691216057308f * (x + 0.044715f * x * x * x);
                const float yv = hv * (x * sigm(u2)); y[4 * jj + e] = yv; ss += yv * yv; } }
        const float r = rsqrtf(wave_sum(ss) * (1.0f / 512.0f) + EPS);
        bf16* op = mixed + tok * 2048 + 1536 + 4 * lane;
        u32x2 w0, w1; w0.x = pk2(y[0] * r, y[1] * r); w0.y = pk2(y[2] * r, y[3] * r); w1.x = pk2(y[4] * r, y[5] * r); w1.y = pk2(y[6] * r, y[7] * r);
        *(u32x2*)op = w0; *(u32x2*)(op + 256) = w1;
    }
    __syncthreads();
}

#define RLX_AGENT __ATOMIC_RELAXED, __HIP_MEMORY_SCOPE_AGENT
#define VM_WAIT() asm volatile("s_waitcnt vmcnt(0)" ::: "memory")
#define XB_TMO      128
#define XB_XCNT(j)  (256  + 64 * (j))
#define XB_XSUB(j)  (1280 + 64 * (j))
#define XB_XGEN(j)  (2304 + 64 * (j))
#define XB_TOP      3328
#define XB_TOPGEN   3392
#define XCD_BAR_WORDS 3456
#define XB_SPIN_CAP (1u << 18)

__device__ __forceinline__ unsigned xb_ld(unsigned* p)              { return __hip_atomic_load(p, __ATOMIC_RELAXED, __HIP_MEMORY_SCOPE_AGENT); }
__device__ __forceinline__ unsigned xb_add(unsigned* p, unsigned v) { return __hip_atomic_fetch_add(p, v, __ATOMIC_RELAXED, __HIP_MEMORY_SCOPE_AGENT); }
__device__ __forceinline__ unsigned xb_xcc_id() { return (unsigned)__builtin_amdgcn_s_getreg((3 << 11) | 20) & 0xFu; }
#define XB_SPIN(cond, bar) do { unsigned _sp = 0; while (cond) { __builtin_amdgcn_s_sleep(1); \
    if ((++_sp & 255u) == 0u) { if (xb_ld(&(bar)[XB_TMO])) break; if (_sp > XB_SPIN_CAP) { atomicAdd(&(bar)[XB_TMO], 1u); break; } } } } while (0)

struct XcdBarrier {
    unsigned* bar; unsigned x;
    volatile LAS unsigned* st;
};

__device__ __forceinline__ XcdBarrier xcd_barrier_post(unsigned* bar, volatile LAS unsigned* st) {
    XcdBarrier b; b.bar = bar; b.x = xb_xcc_id(); b.st = st;
    if (threadIdx.x == 0) (void)xb_add(&bar[XB_XCNT(b.x)], 1u);
    return b;
}
__device__ __forceinline__ void xcd_barrier_complete(unsigned* bar, unsigned x, unsigned& nloc, unsigned& nx) {
    const unsigned G = gridDim.x * gridDim.y * gridDim.z;
    unsigned sum, cnt, mine, sp = 0u;
    for (;;) {
        sum = 0u; cnt = 0u; mine = 0u;
#pragma unroll
        for (unsigned j = 0; j < 16; ++j) { const unsigned c = xb_ld(&bar[XB_XCNT(j)]); sum += c; cnt += (c > 0u) ? 1u : 0u; mine = (j == x) ? c : mine; }
        if (sum == G) break;
        __builtin_amdgcn_s_sleep(1);
        if ((++sp & 255u) == 0u) { if (xb_ld(&bar[XB_TMO])) break; if (sp > XB_SPIN_CAP) { atomicAdd(&bar[XB_TMO], 1u); break; } }
    }
    nloc = mine > 0u ? mine : 1u; nx = cnt > 0u ? cnt : 1u;
}

__device__ __forceinline__ void xcd_barrier(const XcdBarrier& b) {
    asm volatile("s_waitcnt vmcnt(0)" ::: "memory");
    __syncthreads();
    if (threadIdx.x == 0) {
        unsigned* bar = b.bar;
        __builtin_amdgcn_s_waitcnt(0);
        unsigned nloc = b.st[0], nx = b.st[1];
        if (nloc == 0u) { xcd_barrier_complete(bar, b.x, nloc, nx); b.st[0] = nloc; b.st[1] = nx; }
        const unsigned old = xb_add(&bar[XB_XSUB(b.x)], 1u);
        const unsigned gen = old / nloc;
        if (old + 1u == (gen + 1u) * nloc) {
            __builtin_amdgcn_fence(__ATOMIC_RELEASE, "agent");
            asm volatile("s_waitcnt vmcnt(0)" ::: "memory");
            const unsigned og = xb_add(&bar[XB_TOP], 1u);
            const unsigned tg = og / nx;
            if (og + 1u == (tg + 1u) * nx) xb_add(&bar[XB_TOPGEN], 1u);
            else XB_SPIN(xb_ld(&bar[XB_TOPGEN]) == tg, bar);
            __builtin_amdgcn_fence(__ATOMIC_ACQUIRE, "agent");
            xb_add(&bar[XB_XGEN(b.x)], 1u);
            asm volatile("s_waitcnt vmcnt(0)" ::: "memory");
        } else {
            XB_SPIN(xb_ld(&bar[XB_XGEN(b.x)]) == gen, bar);
            __builtin_amdgcn_fence(__ATOMIC_ACQUIRE, "agent");
            asm volatile("s_waitcnt vmcnt(0)" ::: "memory");
        }
    }
    __syncthreads();
}

#ifdef SKIP_GEMM
#define GEMMCALL if (0)
#else
#define GEMMCALL
#endif
#ifdef PROBE_SYNC2
#define GSYNC() do { xcd_barrier(xbar); xcd_barrier(xbar); } while (0)
#else
#define GSYNC() xcd_barrier(xbar)
#endif
#ifdef PROBE_MIX2
#define MIXREP 2
#else
#define MIXREP 1
#endif
#define PHASE_PTRS() unsigned z_, zv_; asm volatile("v_mov_b32 %0, 0" : "=v"(zv_)); z_ = __builtin_amdgcn_readfirstlane(zv_); \
    const int tidp = (int)threadIdx.x + (int)zv_, lanep = tidp & 63, wavep = __builtin_amdgcn_readfirstlane(tidp >> 6), gwp = bx * NWAVES + wavep; (void)lanep; (void)gwp; \
    const __attribute__((address_space(4))) Args* ap = (const __attribute__((address_space(4))) Args*)((const __attribute__((address_space(4))) char*)__builtin_amdgcn_kernarg_segment_ptr() + z_); \
    unsigned char* ws = ap->ws; const unsigned char* wl = ws + WS_W + (size_t)l * WL_STRIDE; (void)wl; const int Gp = G + (int)z_, bxp = bx + (int)z_; (void)Gp; (void)bxp
__global__ void __launch_bounds__(NTHREADS, 2) fwd_megakernel(Args a) {
    extern __shared__ __attribute__((aligned(16))) unsigned char lds_raw[];
    cg::grid_group grid = cg::this_grid();
    LAS unsigned char* lds = (LAS unsigned char*)lds_raw;
    const int tid = threadIdx.x, lane = tid & 63, wave = __builtin_amdgcn_readfirstlane(tid >> 6);
    const int G = gridDim.x, bx = blockIdx.x, gw = bx * NWAVES + wave, ngw = G * NWAVES;
    (void)gw; (void)lane;
    volatile LAS unsigned* xst = (volatile LAS unsigned*)(lds + LDS_BYTES - 64);
    if (tid < 16) xst[tid] = 0u;
    __syncthreads();
    const XcdBarrier xbar = xcd_barrier_post((unsigned*)(a.ws + WS_CTL), xst);

    { const int l = 0; PHASE_PTRS(); LAS float* scr = (LAS float*)(lds + wavep * 16640);
#ifndef SKIP_CVT
        for (int it = gwp; it < DEPTH * IT_LAYER; it += ngw) convert_item(ap, it, scr, lanep);
#ifdef PROBE_CVT2
        for (int it = gwp; it < DEPTH * IT_LAYER; it += ngw) convert_item(ap, it, scr, lanep);
#endif
#endif
        row_init(ap->in[0], ap->out, (bf16*)(ws + WS_U), gwp, ngw, lanep); }
    grid.sync();

#pragma unroll 1
    for (int l = 0; l < DEPTH; ++l) {
        { PHASE_PTRS(); pg8::Gemm g{(const pg8::bf16_t*)(ws + WS_U), (const pg8::bf16_t*)(wl + WL_MAIN), MTOK, 4096, DM}; pg8::StaticOrder S; S.init(MTOK, 4096, Gp, bxp);
            typedef pg8::EpiWs<0, WS_QK, WS_UGLU, WS_RXY> EpiT; EpiT E{ws};
            GEMMCALL pg8::gemm_phase<EpiT, pg8::StaticOrder, true, true>(lds, g, S, E); }
        { PHASE_PTRS(); pg8::Gemm g{(const pg8::bf16_t*)(wl + WL_V), (const pg8::bf16_t*)(ws + WS_U), 1024, MTOK, DM}; pg8::StaticOrder S; S.init(1024, MTOK, Gp, bxp);
            typedef pg8::EpiWs<1, WS_VT, 0, 0> EpiT; EpiT E{ws};
            GEMMCALL pg8::gemm_phase<EpiT, pg8::StaticOrder, true, true>(lds, g, S, E); }
        GSYNC();
#pragma unroll 1
        for (int rep = 0; rep < MIXREP; ++rep)
#pragma unroll 1
        for (int unit = bx; unit < 256; unit += G) {
#ifndef SKIP_ATTN
            { PHASE_PTRS(); attn_unit((const bf16*)(ws + WS_QK), (const bf16*)(ws + WS_VT), (bf16*)(ws + WS_MIXED), unit >> 6, unit & 63, (LAS float*)lds, wavep, lanep); }
#endif
#ifndef SKIP_CONV
            { PHASE_PTRS(); conv_unit((const bf16*)(ws + WS_UGLU), ap->in[10] + (size_t)l * 31 * 512, ap->in[11] + l * 512, ap->in[12] + l * 512, ap->in[13] + l * 512, (bf16*)(ws + WS_MIXED), unit * 32, lds, tidp, wavep, lanep); }
#endif
#ifndef SKIP_LRU1
            { PHASE_PTRS(); float* SUMA = (float*)(ws + WS_SUM);
              lru1_unit((const bf16*)(ws + WS_RXY), ap->in[14] + (size_t)l * 4 * 512, ap->in[15] + l * 512, (const bf16*)(wl + WL_LRU), ap->in[17] + l * 512, ap->in[19] + l * 512, ap->in[20] + l * 512,
                      (float*)(ws + WS_HLOC), (float*)(ws + WS_ACUM), SUMA, SUMA + 256 * 512, unit * 32, lds, tidp, wavep, lanep); }
#endif
        }
        GSYNC();
#pragma unroll 1
        for (int unit = bx; unit < 256; unit += G) { PHASE_PTRS(); float* SUMA = (float*)(ws + WS_SUM);
            lru2_unit((const bf16*)(ws + WS_RXY), (const float*)(ws + WS_HLOC), (const float*)(ws + WS_ACUM), SUMA, SUMA + 256 * 512, (bf16*)(ws + WS_MIXED), unit * 32, lds, tidp, wavep, lanep); }
        GSYNC();
        { PHASE_PTRS(); pg8::Gemm g{(const pg8::bf16_t*)(ws + WS_MIXED), (const pg8::bf16_t*)(wl + WL_OUT), MTOK, DM, DM}; pg8::StaticOrder S; S.init(MTOK, DM, Gp, bxp);
            typedef pg8::EpiWs<3, WS_O, 0, 0> EpiT; EpiT E{ws};
            GEMMCALL pg8::gemm_phase<EpiT, pg8::StaticOrder, true, true>(lds, g, S, E); }
        GSYNC();
        { PHASE_PTRS(); row_res((const float*)(ws + WS_O), ap->in[4] + l * DM, ap->out, (bf16*)(ws + WS_U), true, gwp, ngw, lanep); }
        GSYNC();
        { PHASE_PTRS(); pg8::Gemm g{(const pg8::bf16_t*)(ws + WS_U), (const pg8::bf16_t*)(wl + WL_GU), MTOK, NGU, DM}; pg8::StaticOrder S; S.init(MTOK, NGU, Gp, bxp);
            typedef pg8::EpiWs<2, 0, WS_F, 0> EpiT; EpiT E{ws};
            GEMMCALL pg8::gemm_phase<EpiT, pg8::StaticOrder, true, true>(lds, g, S, E); }
        GSYNC();
        { PHASE_PTRS(); pg8::Gemm g{(const pg8::bf16_t*)(ws + WS_F), (const pg8::bf16_t*)(wl + WL_DOWN), MTOK, DM, DFF}; pg8::StaticOrder S; S.init(MTOK, DM, Gp, bxp);
            typedef pg8::EpiWs<3, WS_O, 0, 0> EpiT; EpiT E{ws};
            GEMMCALL pg8::gemm_phase<EpiT, pg8::StaticOrder, true, true>(lds, g, S, E); }
        GSYNC();
        { PHASE_PTRS(); row_res((const float*)(ws + WS_O), ap->in[6] + l * DM, ap->out, (bf16*)(ws + WS_U), l + 1 < DEPTH, gwp, ngw, lanep); }
        if (l + 1 < DEPTH) GSYNC();
    }
}

extern "C" void kernel_launch(void* const* d_in, const int* in_sizes, int n_in, void* d_out, int out_size, void* d_ws, size_t ws_size, hipStream_t stream) {
    static int grid = 0;
    if (grid == 0) {
        if (n_in != 24 || out_size != MTOK * DM || ws_size < WS_END) { fprintf(stderr, "kernel_launch: unexpected shapes (n_in %d out %d ws %zu)\n", n_in, out_size, ws_size); grid = -1; return; }
        int dev = 0, cus = 0, per_cu = 0;
        (void)hipGetDevice(&dev); (void)hipDeviceGetAttribute(&cus, hipDeviceAttributeMultiprocessorCount, dev);
        (void)hipFuncSetAttribute((const void*)fwd_megakernel, hipFuncAttributeMaxDynamicSharedMemorySize, LDS_BYTES);
        if (hipOccupancyMaxActiveBlocksPerMultiprocessor(&per_cu, (const void*)fwd_megakernel, NTHREADS, LDS_BYTES) != hipSuccess || per_cu < 1) per_cu = 1;
        (void)hipGetLastError();
        grid = cus * per_cu; if (grid > 256) grid = 256; if (grid < 1) grid = 256;
    }
    if (grid < 0) return;
    Args a{};
    for (int i = 0; i < 24; ++i) a.in[i] = (const float*)d_in[i];
    a.out = (float*)d_out; a.ws = (unsigned char*)d_ws;
    if (hipMemsetAsync((char*)d_ws + WS_CTL, 0, CTL_BYTES, stream) != hipSuccess) { fprintf(stderr, "kernel_launch: memset failed\n"); return; }
    void* args[] = {&a};
    hipError_t e = hipLaunchCooperativeKernel((const void*)fwd_megakernel, dim3(grid), dim3(NTHREADS), args, LDS_BYTES, stream);
    if (e != hipSuccess) fprintf(stderr, "kernel_launch: cooperative launch failed: %s (grid %d)\n", hipGetErrorString(e), grid);
}
```
